# Optimizing an MI355X kernel written in HIP

```python
import math
import jax
import jax.numpy as jnp
from jax import lax
import numpy as np

D_MODEL = 2048
BATCH = 4
SEQ = 2048
DEPTH = 1
DEC_BATCH = 128
DEC_SEQ = 1
PAST_LEN = 16384
PAGE_SIZE = 128

POOL_WIDTH = D_MODEL // 2
POOL_WINDOWS = (2, 4, 8, 16)
POOL_GROUPS = len(POOL_WINDOWS)
POOL_GROUP_DIM = POOL_WIDTH // POOL_GROUPS
POOL_BUF = max(POOL_WINDOWS) - 1

SSM_WIDTH = D_MODEL // 2
SSM_GROUP_CH = 16
SSM_GROUPS = SSM_WIDTH // SSM_GROUP_CH
SSM_STATE = 64
SSM_DT_MIN = 0.001
SSM_DT_MAX = 0.1

XA_HEADS = 4
XA_HEAD_DIM = D_MODEL // 8
XA_WIDTH = XA_HEADS * XA_HEAD_DIM
XA_SCALE = XA_HEAD_DIM ** -0.5
N_MEM = 256

N_BRANCH = 3
OFF_SSM = POOL_WIDTH
OFF_XA = POOL_WIDTH + SSM_WIDTH
OFF_GATE = POOL_WIDTH + SSM_WIDTH + XA_WIDTH
IN_WIDTH = OFF_GATE + N_BRANCH * D_MODEL

D_FF = 256 * ((8 * D_MODEL // 3 + 255) // 256)
RMS_EPS = 1e-6

kernel_name = 'hybrid_pool_s5_memxattn_step'


def rmsnorm(x, g):
    xf = x.astype(jnp.float32)
    y = xf * lax.rsqrt(jnp.mean(xf * xf, axis=-1, keepdims=True) + RMS_EPS)
    return (y * g.astype(jnp.float32)).astype(x.dtype)


def swiglu(x, w_gate, w_up, w_down):
    return (jax.nn.silu(x @ w_gate) * (x @ w_up)) @ w_down


def multiscale_pool(u, buf, pos, w_grp, scale, w_proj):
    b, l, _ = u.shape
    ext = jnp.concatenate([buf.astype(jnp.float32), u.astype(jnp.float32)], axis=1)
    cs = jnp.concatenate([jnp.zeros_like(ext[:, :1]), jnp.cumsum(ext, axis=1)], axis=1)
    end = cs[:, POOL_BUF + 1:]
    means = []
    for k, w in enumerate(POOL_WINDOWS):
        ch = slice(k * POOL_GROUP_DIM, (k + 1) * POOL_GROUP_DIM)
        start = POOL_BUF + 1 - w
        win_sum = end[..., ch] - cs[:, start:start + l, ch]
        count = jnp.minimum(pos + 1, w).astype(jnp.float32)[None, :, None]
        means.append(win_sum / count)
    diff = jnp.concatenate(means, axis=-1) - ext[:, POOL_BUF:]
    diff = diff.astype(u.dtype).reshape(b, l, POOL_GROUPS, POOL_GROUP_DIM)
    z = jnp.einsum('blgc,gcd->blgd', diff, w_grp).reshape(b, l, POOL_WIDTH) * scale
    return z @ w_proj, ext[:, -POOL_BUF:].astype(buf.dtype)


def _cplx_affine_combine(e1, e2):
    a1r, a1i, b1r, b1i = e1
    a2r, a2i, b2r, b2i = e2
    return (a1r * a2r - a1i * a2i,
            a1r * a2i + a1i * a2r,
            a2r * b1r - a2i * b1i + b2r,
            a2r * b1i + a2i * b1r + b2i)


def s5_ssm(u, h_re, h_im, a_re, a_im, log_step, b_re, b_im, c_re, c_im, d_skip):
    bt, l, _ = u.shape
    f32 = jnp.float32
    uf = u.astype(f32).reshape(bt, l, SSM_GROUPS, SSM_GROUP_CH)
    a_re = a_re.astype(f32)
    a_im = a_im.astype(f32)
    dt = jnp.exp(log_step.astype(f32))[:, None]
    mag = jnp.exp(a_re * dt)
    ang = a_im * dt
    lb_re = mag * jnp.cos(ang)
    lb_im = mag * jnp.sin(ang)
    den = a_re * a_re + a_im * a_im
    n_re = lb_re - 1.0
    f_re = (n_re * a_re + lb_im * a_im) / den
    f_im = (lb_im * a_re - n_re * a_im) / den
    b_re = b_re.astype(f32)
    b_im = b_im.astype(f32)
    bb_re = f_re[..., None] * b_re - f_im[..., None] * b_im
    bb_im = f_re[..., None] * b_im + f_im[..., None] * b_re
    bu_re = jnp.einsum('blgh,gnh->blgn', uf, bb_re)
    bu_im = jnp.einsum('blgh,gnh->blgn', uf, bb_im)
    h_re = h_re.astype(f32)
    h_im = h_im.astype(f32)
    bu_re = bu_re.at[:, 0].add(lb_re * h_re - lb_im * h_im)
    bu_im = bu_im.at[:, 0].add(lb_re * h_im + lb_im * h_re)
    a_seq_re = jnp.broadcast_to(lb_re, (1, l) + lb_re.shape)
    a_seq_im = jnp.broadcast_to(lb_im, (1, l) + lb_im.shape)
    _, _, x_re, x_im = lax.associative_scan(
        _cplx_affine_combine, (a_seq_re, a_seq_im, bu_re, bu_im), axis=1)
    y = (jnp.einsum('blgn,ghn->blgh', x_re, c_re.astype(f32))
         - jnp.einsum('blgn,ghn->blgh', x_im, c_im.astype(f32)))
    y = y.reshape(bt, l, SSM_WIDTH) + d_skip.astype(f32) * uf.reshape(bt, l, SSM_WIDTH)
    return y.astype(u.dtype), x_re[:, -1], x_im[:, -1]


def memory_kv(mem, g_mem, w_mem_k, w_mem_v):
    b, m, _ = mem.shape
    mn = rmsnorm(mem, g_mem)
    k = (mn @ w_mem_k).reshape(b, m, XA_HEADS, XA_HEAD_DIM)
    v = (mn @ w_mem_v).reshape(b, m, XA_HEADS, XA_HEAD_DIM)
    return k, v


def cross_attend(q, mem_k, mem_v, w_o):
    b, l, _ = q.shape
    qh = q.reshape(b, l, XA_HEADS, XA_HEAD_DIM).astype(jnp.float32)
    s = jnp.einsum('blhd,bmhd->bhlm', qh, mem_k.astype(jnp.float32)) * XA_SCALE
    p = jax.nn.softmax(s, axis=-1)
    o = jnp.einsum('bhlm,bmhd->blhd', p, mem_v.astype(jnp.float32)).astype(q.dtype)
    return o.reshape(b, l, XA_WIDTH) @ w_o


def decoder_layer(x, pos, mem_k, mem_v, pool_buf, h_re, h_im, p):
    b, l, _ = x.shape
    h = x + 0.5 * rmsnorm(swiglu(rmsnorm(x, p['g_ff1_pre']), p['w_ff1_gate'], p['w_ff1_up'],
                                  p['w_ff1_down']), p['g_ff1_post'])
    xn = rmsnorm(h, p['g_mix_pre'])
    proj = xn @ p['w_in']
    u_pool, u_ssm, q, gate_logits = jnp.split(proj, [OFF_SSM, OFF_XA, OFF_GATE], axis=-1)
    o_pool, new_buf = multiscale_pool(u_pool, pool_buf, pos, p['w_pool_grp'], p['pool_scale'],
                                      p['w_pool_out'])
    y_ssm, new_re, new_im = s5_ssm(u_ssm, h_re, h_im, p['ssm_a_re'], p['ssm_a_im'], p['ssm_log_step'],
                                   p['ssm_b_re'], p['ssm_b_im'], p['ssm_c_re'], p['ssm_c_im'],
                                   p['ssm_d'])
    g = jax.nn.gelu(y_ssm)
    o_ssm = (g @ p['w_glu_val']) * jax.nn.sigmoid(g @ p['w_glu_gate'])
    o_xa = cross_attend(q, mem_k, mem_v, p['w_xa_out'])
    gates = jax.nn.sigmoid(gate_logits.reshape(b, l, N_BRANCH, D_MODEL))
    merged = gates[:, :, 0] * o_pool + gates[:, :, 1] * o_ssm + gates[:, :, 2] * o_xa
    h = h + rmsnorm(merged @ p['w_out'], p['g_mix_post'])
    h = h + 0.5 * rmsnorm(swiglu(rmsnorm(h, p['g_ff2_pre']), p['w_ff2_gate'], p['w_ff2_up'],
                                  p['w_ff2_down']), p['g_ff2_post'])
    return h, new_buf, new_re, new_im


def setup_inputs(seed: int = 0) -> dict:
    key = jax.random.key(seed)
    keys = jax.random.split(key, 48)
    counter = [0]
    f32 = jnp.float32

    def nk():
        k = keys[counter[0]]
        counter[0] += 1
        return k

    def dense(shape, fan_in):
        return jax.random.normal(nk(), shape, f32) * fan_in ** -0.5

    def gain():
        return 1.0 + 0.02 * jax.random.normal(nk(), (DEPTH, D_MODEL), f32)

    L = DEPTH
    inp = {}
    inp['x_prompt'] = jax.random.normal(nk(), (BATCH, SEQ, D_MODEL), f32)
    inp['x_sample'] = jax.random.normal(nk(), (DEC_BATCH, DEC_SEQ, D_MODEL), f32)
    inp['mem_prompt'] = jax.random.normal(nk(), (BATCH, N_MEM, D_MODEL), f32)
    inp['cache_mem_k'] = jax.random.normal(nk(), (L, DEC_BATCH, N_MEM, XA_HEADS, XA_HEAD_DIM), f32)
    inp['cache_mem_v'] = jax.random.normal(nk(), (L, DEC_BATCH, N_MEM, XA_HEADS, XA_HEAD_DIM), f32)
    inp['state_pool'] = jax.random.normal(nk(), (L, DEC_BATCH, POOL_BUF, POOL_WIDTH), f32)
    inp['state_ssm_re'] = 0.1 * jax.random.normal(nk(), (L, DEC_BATCH, SSM_GROUPS, SSM_STATE), f32)
    inp['state_ssm_im'] = 0.1 * jax.random.normal(nk(), (L, DEC_BATCH, SSM_GROUPS, SSM_STATE), f32)
    inp['g_ff1_pre'] = gain()
    inp['w_ff1_gate'] = dense((L, D_MODEL, D_FF), D_MODEL)
    inp['w_ff1_up'] = dense((L, D_MODEL, D_FF), D_MODEL)
    inp['w_ff1_down'] = dense((L, D_FF, D_MODEL), D_FF)
    inp['g_ff1_post'] = gain()
    inp['g_mix_pre'] = gain()
    inp['w_in'] = dense((L, D_MODEL, IN_WIDTH), D_MODEL)
    inp['w_pool_grp'] = dense((L, POOL_GROUPS, POOL_GROUP_DIM, POOL_GROUP_DIM), POOL_GROUP_DIM)
    inp['pool_scale'] = 1.0 + 0.1 * jax.random.normal(nk(), (L, POOL_WIDTH), f32)
    inp['w_pool_out'] = dense((L, POOL_WIDTH, D_MODEL), POOL_WIDTH)
    inp['ssm_a_re'] = -0.5 * jnp.exp(0.05 * jax.random.normal(nk(), (L, SSM_GROUPS, SSM_STATE), f32))
    n_idx = jnp.arange(SSM_STATE, dtype=f32)[None, None, :]
    inp['ssm_a_im'] = math.pi * n_idx + 0.01 * jax.random.normal(nk(), (L, SSM_GROUPS, SSM_STATE), f32)
    inp['ssm_log_step'] = jax.random.uniform(nk(), (L, SSM_GROUPS), f32,
                                             minval=math.log(SSM_DT_MIN), maxval=math.log(SSM_DT_MAX))
    inp['ssm_b_re'] = dense((L, SSM_GROUPS, SSM_STATE, SSM_GROUP_CH), 2 * SSM_GROUP_CH)
    inp['ssm_b_im'] = dense((L, SSM_GROUPS, SSM_STATE, SSM_GROUP_CH), 2 * SSM_GROUP_CH)
    inp['ssm_c_re'] = dense((L, SSM_GROUPS, SSM_GROUP_CH, SSM_STATE), 2 * SSM_STATE)
    inp['ssm_c_im'] = dense((L, SSM_GROUPS, SSM_GROUP_CH, SSM_STATE), 2 * SSM_STATE)
    inp['ssm_d'] = jax.random.normal(nk(), (L, SSM_WIDTH), f32)
    inp['w_glu_val'] = dense((L, SSM_WIDTH, D_MODEL), SSM_WIDTH)
    inp['w_glu_gate'] = dense((L, SSM_WIDTH, D_MODEL), SSM_WIDTH)
    inp['g_mem'] = gain()
    inp['w_mem_k'] = dense((L, D_MODEL, XA_WIDTH), D_MODEL)
    inp['w_mem_v'] = dense((L, D_MODEL, XA_WIDTH), D_MODEL)
    inp['w_xa_out'] = dense((L, XA_WIDTH, D_MODEL), XA_WIDTH)
    inp['w_out'] = dense((L, D_MODEL, D_MODEL), D_MODEL)
    inp['g_mix_post'] = gain()
    inp['g_ff2_pre'] = gain()
    inp['w_ff2_gate'] = dense((L, D_MODEL, D_FF), D_MODEL)
    inp['w_ff2_up'] = dense((L, D_MODEL, D_FF), D_MODEL)
    inp['w_ff2_down'] = dense((L, D_FF, D_MODEL), D_FF)
    inp['g_ff2_post'] = gain()
    return inp


def reference(x_prompt, x_sample, mem_prompt, cache_mem_k, cache_mem_v, state_pool, state_ssm_re,
              state_ssm_im, g_ff1_pre, w_ff1_gate, w_ff1_up, w_ff1_down, g_ff1_post, g_mix_pre, w_in,
              w_pool_grp, pool_scale, w_pool_out, ssm_a_re, ssm_a_im, ssm_log_step, ssm_b_re, ssm_b_im,
              ssm_c_re, ssm_c_im, ssm_d, w_glu_val, w_glu_gate, g_mem, w_mem_k, w_mem_v, w_xa_out,
              w_out, g_mix_post, g_ff2_pre, w_ff2_gate, w_ff2_up, w_ff2_down, g_ff2_post):
    weights = dict(g_ff1_pre=g_ff1_pre, w_ff1_gate=w_ff1_gate, w_ff1_up=w_ff1_up, w_ff1_down=w_ff1_down,
                   g_ff1_post=g_ff1_post, g_mix_pre=g_mix_pre, w_in=w_in, w_pool_grp=w_pool_grp,
                   pool_scale=pool_scale, w_pool_out=w_pool_out, ssm_a_re=ssm_a_re, ssm_a_im=ssm_a_im,
                   ssm_log_step=ssm_log_step, ssm_b_re=ssm_b_re, ssm_b_im=ssm_b_im, ssm_c_re=ssm_c_re,
                   ssm_c_im=ssm_c_im, ssm_d=ssm_d, w_glu_val=w_glu_val, w_glu_gate=w_glu_gate,
                   w_xa_out=w_xa_out, w_out=w_out, g_mix_post=g_mix_post, g_ff2_pre=g_ff2_pre,
                   w_ff2_gate=w_ff2_gate, w_ff2_up=w_ff2_up, w_ff2_down=w_ff2_down, g_ff2_post=g_ff2_post)
    bp, lp, _ = x_prompt.shape
    ls = x_sample.shape[1]
    pos_p = jnp.arange(lp, dtype=jnp.int32)
    pos_s = PAST_LEN + jnp.arange(ls, dtype=jnp.int32)
    hp, hs = x_prompt, x_sample
    mk_l, mv_l, pp_l, rp_l, ip_l, ps_l, rs_l, is_l = [], [], [], [], [], [], [], []
    for layer in range(DEPTH):
        p = {name: w[layer] for name, w in weights.items()}
        mk, mv = memory_kv(mem_prompt, g_mem[layer], w_mem_k[layer], w_mem_v[layer])
        pool0 = jnp.zeros((bp, POOL_BUF, POOL_WIDTH), x_prompt.dtype)
        ssm0 = jnp.zeros((bp, SSM_GROUPS, SSM_STATE), jnp.float32)
        hp, pb, sr, si = decoder_layer(hp, pos_p, mk, mv, pool0, ssm0, ssm0, p)
        hs, pbs, srs, sis = decoder_layer(hs, pos_s, cache_mem_k[layer], cache_mem_v[layer],
                                          state_pool[layer], state_ssm_re[layer], state_ssm_im[layer], p)
        mk_l.append(mk.astype(cache_mem_k.dtype))
        mv_l.append(mv.astype(cache_mem_v.dtype))
        pp_l.append(pb.astype(state_pool.dtype))
        rp_l.append(sr.astype(state_ssm_re.dtype))
        ip_l.append(si.astype(state_ssm_im.dtype))
        ps_l.append(pbs.astype(state_pool.dtype))
        rs_l.append(srs.astype(state_ssm_re.dtype))
        is_l.append(sis.astype(state_ssm_im.dtype))
    return (hp, hs, jnp.stack(mk_l), jnp.stack(mv_l), jnp.stack(pp_l), jnp.stack(rp_l), jnp.stack(ip_l),
            jnp.stack(ps_l), jnp.stack(rs_l), jnp.stack(is_l))
```

```cpp
#include <hip/hip_runtime.h>
#include <cstdio>
#include <cstdint>

#ifndef MK_SINGLE
#define MK_SINGLE 1
#endif

#define LAS __attribute__((address_space(3)))
typedef unsigned short bf16_t;
typedef short bf16x8 __attribute__((ext_vector_type(8)));
typedef short s16x4 __attribute__((ext_vector_type(4)));
typedef float f32x4 __attribute__((ext_vector_type(4)));
typedef unsigned u32x4 __attribute__((ext_vector_type(4)));
typedef unsigned u32x2 __attribute__((ext_vector_type(2)));

constexpr int DM = 2048, SEQ = 2048, NBAT = 4, MP = NBAT * SEQ, MS = 128, MT = MP + MS, MPAD = 8448, NMT = MPAD / 256;
constexpr int DFF = 5632, NMEM = 256, MEMR = NBAT * NMEM;
constexpr int PW = 1024, GW = 6144;
constexpr float RMS_EPS = 1e-6f;
constexpr int NPHASE = 14;
constexpr int NTHREADS = 512, NWAVES = 8;
constexpr int LDS_BYTES = 147456;

constexpr size_t MiB = (size_t)1 << 20;
constexpr size_t WS_W1GU = 1 * MiB, WS_W1D = 45 * MiB, WS_WIN = 67 * MiB, WS_WPG = 103 * MiB, WS_WPO = 104 * MiB, WS_WGLU = 108 * MiB, WS_WXO = 116 * MiB,
                 WS_WOUT = 120 * MiB, WS_WMKV = 128 * MiB, WS_W2GU = 136 * MiB, WS_W2D = 180 * MiB;
constexpr size_t WS_XN = 202 * MiB, WS_ACT = 235 * MiB, WS_F = 334 * MiB, WS_H = 400 * MiB, WS_UP = 466 * MiB, WS_US = 499 * MiB, WS_Q = 532 * MiB,
                 WS_DIFF = 549 * MiB, WS_Z = 566 * MiB, WS_GS = 583 * MiB, WS_XO = 600 * MiB, WS_MB = 617 * MiB, WS_MEMN = 650 * MiB, WS_KB = 654 * MiB, WS_VT = 656 * MiB,
                 WS_SLAB = 658 * MiB, WS_SLAB7 = 680 * MiB, WS_END = 696 * MiB;
constexpr size_t O_Y = 0, O_MK = 17039360, O_MV = 18087936, O_PP = 19136512, O_SRP = 19197952, O_SIP = 19214336, O_PS = 19230720, O_SRS = 21196800, O_SIS = 21721088;

enum { I_XP = 0, I_XS, I_MEM, I_CK, I_CV, I_SPOOL, I_SRE, I_SIM, I_G1PRE, I_W1G, I_W1U, I_W1D, I_G1POST, I_GMIXPRE, I_WIN, I_WPG, I_PSCALE, I_WPO,
       I_ARE, I_AIM, I_LOGSTEP, I_BRE, I_BIM, I_CRE, I_CIM, I_SSMD, I_WGV, I_WGG, I_GMEM, I_WMK, I_WMV, I_WXO, I_WOUT, I_GMIXPOST, I_G2PRE, I_W2G, I_W2U, I_W2D, I_G2POST, N_IN };

struct Args { const float* in[N_IN]; float* out; unsigned char* ws; int ph_lo, ph_hi; };

#define LDS_WAIT() asm volatile("s_waitcnt lgkmcnt(0)" ::: "memory")
__device__ __forceinline__ unsigned cvt_pk_bf16(float lo, float hi) { unsigned r; asm volatile("v_cvt_pk_bf16_f32 %0, %1, %2" : "=v"(r) : "v"(lo), "v"(hi)); return r; }
__device__ __forceinline__ float bf2f(unsigned short b) { return __uint_as_float(((unsigned)b) << 16); }
__device__ __forceinline__ float wave_sum(float v) {
#pragma unroll
    for (int o = 1; o < 64; o <<= 1) v += __shfl_xor(v, o);
    return v;
}
__device__ __forceinline__ float wave_max(float v) {
#pragma unroll
    for (int o = 1; o < 64; o <<= 1) v = fmaxf(v, __shfl_xor(v, o));
    return v;
}
__device__ __forceinline__ float sigm(float x) { return __builtin_amdgcn_rcpf(1.0f + __expf(-x)); }
__device__ __forceinline__ float gelu_tanh(float x) {
    const float z = 0.7978845608028654f * (x + 0.044715f * x * x * x);
    const float e = __expf(2.0f * z);
    const float th = 1.0f - 2.0f * __builtin_amdgcn_rcpf(e + 1.0f);
    return 0.5f * x * (1.0f + th);
}

__device__ __forceinline__ size_t us_off(size_t row, int c) {
    const int g = c >> 4, w = c & 15;
    return row < (size_t)MP ? ((((row >> 11) * 64 + g) * 2048 + (row & 2047)) * 16 + w) : ((size_t)NBAT * 64 * 2048 * 16 + ((size_t)g * 256 + (row - MP)) * 16 + w);
}
namespace pg8 {
constexpr int BM = 256, BK = 64, HALF = 128, HTB = HALF * BK * 2, STAGE_BYTES = 8 * HTB;
__device__ __forceinline__ int lds_byte(int r, int c) { const int st = (r >> 4) * 2 + (c >> 5), rr = r & 15, cc = c & 31, ob = rr * 64 + cc * 2; return st * 1024 + (ob ^ (((ob >> 9) & 1) << 5)); }
__device__ __forceinline__ void stage_rc(int b, int& R, int& C) { const int st = b / 1024, sb = b % 1024, swz = sb ^ (((sb >> 9) & 1) << 5); R = (st >> 1) * 16 + swz / 64; C = (st & 1) * 32 + (swz % 64) / 2; }
__device__ __forceinline__ int perm32(int rho) { const int n = rho >> 4, i = rho & 15; return 8 * (i >> 2) + 4 * n + (i & 3); }

struct Unit { const char* A; const char* B; int nt, pm, pn, kind, aux; };

__device__ __forceinline__ void tile_of(int L, int nM, int nN, int& pm, int& pn) {
    const int nwg = nM * nN; int wgid = L;
    { const int q = nwg / 8, r = nwg % 8, xcd = wgid % 8, off = wgid / 8; wgid = (xcd < r ? xcd * (q + 1) : r * (q + 1) + (xcd - r) * q) + off; }
    const int nig = 8 * nN, gid = wgid / nig, fm = gid * 8, gsz = (nM - fm) < 8 ? (nM - fm) : 8;
    pm = fm + ((wgid % nig) % gsz); pn = (wgid % nig) / gsz;
}

template <class Epi, class Sched>
__device__ __forceinline__ void gemm_phase(LAS unsigned char* lds, const int lda, const int ldb, const Sched& S, const Epi& E) {
    const int tid = threadIdx.x, wid = __builtin_amdgcn_readfirstlane(tid >> 6), lane = tid & 63, wr = wid >> 2, wc = wid & 3, fr = lane & 15, fq = lane >> 4;
    unsigned voffA[2], voffB[2];
#pragma unroll
    for (int i = 0; i < 2; ++i) { int R, C; stage_rc(tid * 16 + i * 8192, R, C); const int Rb = (R & ~31) + perm32(R & 31);
        voffA[i] = (unsigned)(R * lda + C) * 2u; voffB[i] = (unsigned)(Rb * ldb + C) * 2u; }
    const size_t kstep = (size_t)(BK * 2);
    const size_t hstepA = (size_t)HALF * lda * 2, hstepB = (size_t)HALF * ldb * 2;
    const unsigned ldsw = (unsigned)wid * 1024u;
    const int aoff = lds_byte(wr * 64 + fr, fq * 8), boff = lds_byte(wc * 32 + fr, fq * 8);
#define PG8_SA(b, h) (((b) * 2 + (h)) * HTB)
#define PG8_SB(b, h) ((4 + (b) * 2 + (h)) * HTB)
#define PG8_STAGE(bufoff, gbase, voff) do { _Pragma("unroll") for (int _i = 0; _i < 2; ++_i) \
        __builtin_amdgcn_global_load_lds((const unsigned*)((const char*)(gbase) + (voff)[_i]), (LAS unsigned*)(lds + (bufoff) + ldsw + _i * 8192), 16, 0, 0); } while (0)
#define PG8_LDA(dst, b, h) do { _Pragma("unroll") for (int m = 0; m < 4; ++m) _Pragma("unroll") for (int k = 0; k < 2; ++k) dst[m][k] = *(const LAS bf16x8*)(lds + PG8_SA(b, h) + aoff + m * 2048 + k * 1024); } while (0)
#define PG8_LDB(dst, b, h) do { _Pragma("unroll") for (int n = 0; n < 2; ++n) _Pragma("unroll") for (int k = 0; k < 2; ++k) dst[n][k] = *(const LAS bf16x8*)(lds + PG8_SB(b, h) + boff + n * 2048 + k * 1024); } while (0)
#define PG8_MMA(ai, bj, At, Bt) do { __builtin_amdgcn_s_setprio(3); _Pragma("unroll") for (int m = 0; m < 4; ++m) _Pragma("unroll") for (int n = 0; n < 2; ++n) _Pragma("unroll") for (int k = 0; k < 2; ++k) \
        acc[ai][bj][m][n] = __builtin_amdgcn_mfma_f32_16x16x32_bf16(Bt[n][k], At[m][k], acc[ai][bj][m][n], 0, 0, 0); __builtin_amdgcn_s_setprio(0); } while (0)
#define PG8_WAIT_V(n) asm volatile("s_waitcnt vmcnt(" #n ")" ::: "memory")
#define PG8_WAIT_L(n) asm volatile("s_waitcnt lgkmcnt(" #n ")" ::: "memory")
#define PG8_BAR __builtin_amdgcn_s_barrier()
#define PG8_SCHED __builtin_amdgcn_sched_barrier(0)
    Unit cur, nxt; int ui = 0;
    if (!S.next(0, cur)) return;
    f32x4 acc[2][2][4][2];
#pragma unroll
    for (int a = 0; a < 2; ++a)
#pragma unroll
        for (int b = 0; b < 2; ++b)
#pragma unroll
            for (int m = 0; m < 4; ++m)
#pragma unroll
                for (int n = 0; n < 2; ++n) acc[a][b][m][n] = (f32x4){0.f, 0.f, 0.f, 0.f};
    bf16x8 At[4][2], B0[2][2], B1[2][2];
    const char* cA = cur.A; const char* cB = cur.B;
    PG8_STAGE(PG8_SB(0, 0), cB, voffB); PG8_STAGE(PG8_SB(0, 1), cB + hstepB, voffB); PG8_STAGE(PG8_SA(0, 0), cA, voffA); PG8_STAGE(PG8_SA(0, 1), cA + hstepA, voffA);
    if (wr == 1) PG8_BAR;
    PG8_WAIT_V(2); PG8_BAR;
    PG8_STAGE(PG8_SB(1, 0), cB + kstep, voffB); PG8_STAGE(PG8_SA(1, 0), cA + kstep, voffA); PG8_STAGE(PG8_SB(1, 1), cB + hstepB + kstep, voffB);
    PG8_WAIT_V(6); PG8_BAR;
    for (;;) {
        const bool has_next = S.next(ui + 1, nxt);
        const char* nA = has_next ? nxt.A : cA; const char* nB = has_next ? nxt.B : cB;
        const int nt = cur.nt;
        for (int t = 0; t < nt; t += 2) {
            const bool last = (t == nt - 2);
            const char* a1 = cA + (size_t)(t + 1) * kstep;
            const char* a2 = last ? nA : cA + (size_t)(t + 2) * kstep; const char* b2 = last ? nB : cB + (size_t)(t + 2) * kstep;
            const char* a3 = a2 + kstep; const char* b3 = b2 + kstep;
            PG8_LDB(B0, 0, 0); PG8_LDB(B1, 0, 1); PG8_SCHED; PG8_LDA(At, 0, 0); PG8_STAGE(PG8_SA(1, 1), a1 + hstepA, voffA);
            PG8_WAIT_V(8); PG8_WAIT_L(0); PG8_BAR; PG8_MMA(0, 0, At, B0); PG8_MMA(0, 1, At, B1); PG8_BAR; PG8_SCHED;
            PG8_LDA(At, 0, 1); PG8_STAGE(PG8_SB(0, 0), b2, voffB); PG8_STAGE(PG8_SB(0, 1), b2 + hstepB, voffB); PG8_STAGE(PG8_SA(0, 0), a2, voffA);
            PG8_WAIT_V(8); PG8_WAIT_L(0); PG8_BAR; PG8_MMA(1, 0, At, B0); PG8_MMA(1, 1, At, B1); PG8_BAR; PG8_SCHED;
            PG8_LDB(B0, 1, 0); PG8_LDB(B1, 1, 1); PG8_SCHED; PG8_LDA(At, 1, 0); PG8_STAGE(PG8_SA(0, 1), a2 + hstepA, voffA);
            PG8_WAIT_V(8); PG8_WAIT_L(0); PG8_BAR; PG8_MMA(0, 0, At, B0); PG8_MMA(0, 1, At, B1); PG8_BAR; PG8_SCHED;
            PG8_LDA(At, 1, 1); PG8_STAGE(PG8_SB(1, 0), b3, voffB); PG8_STAGE(PG8_SB(1, 1), b3 + hstepB, voffB); PG8_STAGE(PG8_SA(1, 0), a3, voffA);
            PG8_WAIT_V(8); PG8_WAIT_L(0); PG8_BAR; PG8_MMA(1, 0, At, B0); PG8_MMA(1, 1, At, B1); PG8_BAR; PG8_SCHED;
        }
        if (wr == 0) PG8_BAR;
        E(acc, cur, wr, wc, fr, fq);
        if (!has_next) break;
#pragma unroll
        for (int a = 0; a < 2; ++a)
#pragma unroll
            for (int b = 0; b < 2; ++b)
#pragma unroll
                for (int m = 0; m < 4; ++m)
#pragma unroll
                    for (int n = 0; n < 2; ++n) acc[a][b][m][n] = (f32x4){0.f, 0.f, 0.f, 0.f};
        cur = nxt; cA = nA; cB = nB; ++ui;
        if (wr == 1) PG8_BAR;
    }
    PG8_WAIT_V(0);
    PG8_BAR;
#undef PG8_SA
#undef PG8_SB
#undef PG8_STAGE
#undef PG8_LDA
#undef PG8_LDB
#undef PG8_MMA
#undef PG8_WAIT_V
#undef PG8_WAIT_L
#undef PG8_BAR
#undef PG8_SCHED
}

struct Sched2 {
    const char *A0, *B0; int nM0, nN0, nt0; size_t ta0, tb0, ca0;
    const char *A1, *B1; int nM1, nN1, nt1; size_t ta1, tb1, ca1;
    int G, c;
    __device__ __forceinline__ bool next(int i, Unit& u) const {
        int L = i * G + c; const int n0 = nM0 * nN0, n1 = nM1 * nN1;
        if (L < n0) { int pm, pn; tile_of(L, nM0, nN0, pm, pn); u.A = A0 + (size_t)pm * ta0 + (size_t)pn * ca0; u.B = B0 + (size_t)pn * tb0; u.nt = nt0; u.pm = pm; u.pn = pn; u.kind = 0; u.aux = 0; return true; }
        L -= n0;
        if (L < n1) { int pm, pn; tile_of(L, nM1, nN1, pm, pn); u.A = A1 + (size_t)pm * ta1 + (size_t)pn * ca1; u.B = B1 + (size_t)pn * tb1; u.nt = nt1; u.pm = pm; u.pn = pn; u.kind = 1; u.aux = 0; return true; }
        return false;
    }
};
struct SchedN2 {
    const char *A, *B; int nt; size_t ta, tb; int G, c;
    __device__ __forceinline__ bool next(int i, Unit& u) const {
        const int np = c < 256 ? (256 - c + G - 1) / G : 0;
        if (i < np) { int pm, pn; tile_of(i * G + c, 32, 8, pm, pn); u.A = A + (size_t)pm * ta; u.B = B + (size_t)pn * tb; u.nt = nt; u.pm = pm; u.pn = pn; u.kind = 0; u.aux = 0; return true; }
        const int j = (i - np) * G + c;
        if (j >= 8 * (nt >> 2)) return false;
        const int pn = j & 7, kc = j >> 3;
        u.A = A + (size_t)32 * ta + (size_t)kc * 512; u.B = B + (size_t)pn * tb + (size_t)kc * 512; u.nt = 4; u.pm = 32; u.pn = pn; u.kind = 1; u.aux = kc; return true;
    }
};
struct SchedBr {
    const char *Z, *XO, *GS, *WPO, *WXO, *WGLU; int G, c;
    __device__ __forceinline__ bool next(int i, Unit& u) const {
        const int ns = c < 256 ? (256 - c + G - 1) / G : 0;
        const size_t brow = (size_t)256 * 1024 * 2;
        const bool mini_first = (G == 256) && (c < 128);
        if (mini_first) { if (i == 0) i = 4 * ns; else if (i > 4 * ns) return false; else i -= 1; }
        if (i < 4 * ns) {
            const int s = i >> 2, sub = i & 3; int pm, pn; tile_of(s * G + c, 32, 8, pm, pn);
            const size_t arow = (size_t)pm * 256 * 1024 * 2;
            if (sub == 0) { u.A = Z + arow; u.B = WPO + (size_t)pn * brow; }
            else if (sub == 1) { u.A = XO + arow; u.B = WXO + (size_t)pn * brow; }
            else { u.A = GS + arow; u.B = WGLU + (size_t)(2 * pn + (sub - 2)) * brow; }
            u.nt = 16; u.pm = pm; u.pn = pn; u.kind = sub; u.aux = 0; return true;
        }
        const int j = (i - 4 * ns) * G + c;
        if (j >= 128) return false;
        const int tt = j & 31, kc = j >> 5; const size_t arow = (size_t)32 * 256 * 1024 * 2 + (size_t)kc * 512;
        if (tt < 8) { u.A = Z + arow; u.B = WPO + (size_t)tt * brow + (size_t)kc * 512; }
        else if (tt < 16) { u.A = XO + arow; u.B = WXO + (size_t)(tt - 8) * brow + (size_t)kc * 512; }
        else { u.A = GS + arow; u.B = WGLU + (size_t)(tt - 16) * brow + (size_t)kc * 512; }
        u.nt = 4; u.pm = 32; u.pn = tt; u.kind = 4; u.aux = kc; return true;
    }
};

#define EPI_ARGS const f32x4 (&acc)[2][2][4][2], const Unit& u, int wr, int wc, int fr, int fq
__device__ __forceinline__ u32x4 pack8(const f32x4& a, const f32x4& b) { u32x4 w; w.x = cvt_pk_bf16(a[0], a[1]); w.y = cvt_pk_bf16(a[2], a[3]); w.z = cvt_pk_bf16(b[0], b[1]); w.w = cvt_pk_bf16(b[2], b[3]); return w; }

__device__ __forceinline__ size_t frag_off(int tile, int ai, int m, int bj, int wr, int wc, int fr, int fq) {
    return ((size_t)tile * 16 + (size_t)((ai * 4 + m) * 2 + bj)) * 4096 + (size_t)(((wr * 4 + wc) * 64 + fq * 16 + fr) * 8);
}
struct EpiUp {
    bf16_t* ACT; float* outK; float* outV; bf16_t* KB; bf16_t* VT;
    __device__ __forceinline__ void operator()(EPI_ARGS) const {
        if (u.kind == 0) {
            const int row0 = u.pm * 256 + wr * 64 + fr, a0 = u.pn * 128 + wc * 32 + 8 * fq;
#pragma unroll
            for (int ai = 0; ai < 2; ++ai)
#pragma unroll
                for (int m = 0; m < 4; ++m) {
                    f32x4 v0, v1;
#pragma unroll
                    for (int j = 0; j < 4; ++j) { const float g0 = acc[ai][0][m][0][j], g1 = acc[ai][0][m][1][j];
                        v0[j] = g0 * sigm(g0) * acc[ai][1][m][0][j]; v1[j] = g1 * sigm(g1) * acc[ai][1][m][1][j]; }
                    *(u32x4*)(ACT + (size_t)(row0 + ai * 128 + m * 16) * DFF + a0) = pack8(v0, v1);
                }
        } else {
            const int row0 = u.pm * 256 + wr * 64 + fr;
#pragma unroll
            for (int ai = 0; ai < 2; ++ai)
#pragma unroll
                for (int m = 0; m < 4; ++m) {
                    const int r = row0 + ai * 128 + m * 16;
#pragma unroll
                    for (int bj = 0; bj < 2; ++bj) {
                        const int c0 = u.pn * 256 + bj * 128 + wc * 32 + 8 * fq;
                        const f32x4 v0 = acc[ai][bj][m][0], v1 = acc[ai][bj][m][1];
                        if (u.pn < 4) {
                            float* o = outK + (size_t)r * 1024 + c0; *(f32x4*)o = v0; *(f32x4*)(o + 4) = v1;
                            *(u32x4*)(KB + (size_t)r * 1024 + c0) = pack8(v0, v1);
                        } else {
                            const int cc = c0 - 1024;
                            float* o = outV + (size_t)r * 1024 + cc; *(f32x4*)o = v0; *(f32x4*)(o + 4) = v1;
                            const u32x4 w = pack8(v0, v1);
                            bf16_t* vt = VT + ((size_t)((r >> 8) * 4 + (cc >> 8)) * 256 + (cc & 255)) * 256 + (r & 255);
                            vt[0 * 256] = (bf16_t)(w.x & 0xffff); vt[1 * 256] = (bf16_t)(w.x >> 16); vt[2 * 256] = (bf16_t)(w.y & 0xffff); vt[3 * 256] = (bf16_t)(w.y >> 16);
                            vt[4 * 256] = (bf16_t)(w.z & 0xffff); vt[5 * 256] = (bf16_t)(w.z >> 16); vt[6 * 256] = (bf16_t)(w.w & 0xffff); vt[7 * 256] = (bf16_t)(w.w >> 16);
                        }
                    }
                }
        }
    }
};
struct EpiF32 {
    float* F; float* SLAB;
    __device__ __forceinline__ void operator()(EPI_ARGS) const {
        if (u.kind == 0) {
            const int row0 = u.pm * 256 + wr * 64 + fr;
#pragma unroll
            for (int ai = 0; ai < 2; ++ai)
#pragma unroll
                for (int m = 0; m < 4; ++m) {
                    bf16_t* rp = (bf16_t*)F + (size_t)(row0 + ai * 128 + m * 16) * DM + u.pn * 256 + wc * 32 + 8 * fq;
#pragma unroll
                    for (int bj = 0; bj < 2; ++bj) *(u32x4*)(rp + bj * 128) = pack8(acc[ai][bj][m][0], acc[ai][bj][m][1]);
                }
        } else {
#pragma unroll
            for (int m = 0; m < 4; ++m) {
                float* rp = SLAB + ((size_t)u.aux * 128 + wr * 64 + m * 16 + fr) * DM + u.pn * 256 + wc * 32 + 8 * fq;
#pragma unroll
                for (int bj = 0; bj < 2; ++bj) { *(f32x4*)(rp + bj * 128) = acc[0][bj][m][0]; *(f32x4*)(rp + bj * 128 + 4) = acc[0][bj][m][1]; }
            }
        }
    }
};
struct EpiIn {
    float* UP; float* US; bf16_t* Q; bf16_t* G; bf16_t* WPGO;
    __device__ __forceinline__ void operator()(EPI_ARGS) const {
        const int row0 = u.pm * 256 + wr * 64 + fr, pn = u.pn;
        if (u.kind == 1) {
#pragma unroll
            for (int ai = 0; ai < 2; ++ai)
#pragma unroll
                for (int m = 0; m < 4; ++m)
#pragma unroll
                    for (int bj = 0; bj < 2; ++bj)
                        *(u32x4*)(WPGO + (size_t)(row0 + ai * 128 + m * 16) * 1024 + pn * 256 + bj * 128 + wc * 32 + 8 * fq) = pack8(acc[ai][bj][m][0], acc[ai][bj][m][1]);
            return;
        }
#pragma unroll
        for (int ai = 0; ai < 2; ++ai)
#pragma unroll
            for (int m = 0; m < 4; ++m) {
                const size_t r = (size_t)(row0 + ai * 128 + m * 16);
#pragma unroll
                for (int bj = 0; bj < 2; ++bj) {
                    const int c0 = pn * 256 + bj * 128 + wc * 32 + 8 * fq;
                    f32x4 v0 = acc[ai][bj][m][0], v1 = acc[ai][bj][m][1];
                    if (pn < 4) *(u32x4*)((bf16_t*)UP + r * 1024 + c0) = pack8(v0, v1);
                    else if (pn < 8) *(u32x4*)((bf16_t*)US + us_off(r, c0 - 1024)) = pack8(v0, v1);
                    else if (pn < 12) { v0 *= 0.0625f; v1 *= 0.0625f; *(u32x4*)(Q + r * 1024 + (c0 - 2048)) = pack8(v0, v1); }
                    else {
#pragma unroll
                        for (int j = 0; j < 4; ++j) { v0[j] = sigm(v0[j]); v1[j] = sigm(v1[j]); }
                        *(u32x4*)(G + frag_off(u.pm * 24 + (pn - 12), ai, m, bj, wr, wc, fr, fq)) = pack8(v0, v1);
                    }
                }
            }
    }
};
__device__ __forceinline__ void unpack8(const u32x4& w, f32x4& a, f32x4& b) {
    a[0] = __uint_as_float(w.x << 16); a[1] = __uint_as_float(w.x & 0xffff0000u); a[2] = __uint_as_float(w.y << 16); a[3] = __uint_as_float(w.y & 0xffff0000u);
    b[0] = __uint_as_float(w.z << 16); b[1] = __uint_as_float(w.z & 0xffff0000u); b[2] = __uint_as_float(w.w << 16); b[3] = __uint_as_float(w.w & 0xffff0000u);
}
struct EpiBr {
    float* MG; bf16_t* MB; const bf16_t* G; float* SLAB7;
    __device__ __forceinline__ void operator()(EPI_ARGS) const {
        const int row0 = u.pm * 256 + wr * 64 + fr, kind = u.kind;
        if (kind == 4) {
#pragma unroll
            for (int m = 0; m < 4; ++m) {
                float* rp = SLAB7 + ((size_t)u.aux * 128 + wr * 64 + m * 16 + fr) * 8192 + u.pn * 256 + wc * 32 + 8 * fq;
#pragma unroll
                for (int bj = 0; bj < 2; ++bj) { *(f32x4*)(rp + bj * 128) = acc[0][bj][m][0]; *(f32x4*)(rp + bj * 128 + 4) = acc[0][bj][m][1]; }
            }
            return;
        }
        if (kind >= 2) {
            u32x4 gq[2][4], oq[2][4];
#pragma unroll
            for (int ai = 0; ai < 2; ++ai)
#pragma unroll
                for (int m = 0; m < 4; ++m) { gq[ai][m] = *(const u32x4*)(G + frag_off(u.pm * 24 + 8 + u.pn, ai, m, kind - 2, wr, wc, fr, fq)); oq[ai][m] = *(const u32x4*)((const bf16_t*)MG + frag_off(u.pm * 8 + u.pn, ai, m, kind - 2, wr, wc, fr, fq)); }
            __builtin_amdgcn_sched_barrier(0);
#pragma unroll
            for (int ai = 0; ai < 2; ++ai)
#pragma unroll
                for (int m = 0; m < 4; ++m) { const size_t r = (size_t)(row0 + ai * 128 + m * 16); const int c0 = u.pn * 256 + (kind - 2) * 128 + wc * 32 + 8 * fq;
                    f32x4 g0, g1; unpack8(gq[ai][m], g0, g1);
                    f32x4 v0, v1; unpack8(oq[ai][m], v0, v1);
#pragma unroll
                    for (int j = 0; j < 4; ++j) { v0[j] += g0[j] * acc[ai][0][m][0][j] * sigm(acc[ai][1][m][0][j]); v1[j] += g1[j] * acc[ai][0][m][1][j] * sigm(acc[ai][1][m][1][j]); }
                    *(u32x4*)(MB + r * DM + c0) = pack8(v0, v1); }
            return;
        }
#pragma unroll
        for (int ai = 0; ai < 2; ++ai) {
            u32x4 gq[4][2], pq[4][2];
#pragma unroll
            for (int m = 0; m < 4; ++m)
#pragma unroll
                for (int bj = 0; bj < 2; ++bj) {
                    gq[m][bj] = *(const u32x4*)(G + frag_off(u.pm * 24 + (kind == 0 ? 0 : 16) + u.pn, ai, m, bj, wr, wc, fr, fq));
                    if (kind == 1) pq[m][bj] = *(const u32x4*)((const bf16_t*)MG + frag_off(u.pm * 8 + u.pn, ai, m, bj, wr, wc, fr, fq)); }
            __builtin_amdgcn_sched_barrier(0);
#pragma unroll
            for (int m = 0; m < 4; ++m)
#pragma unroll
                for (int bj = 0; bj < 2; ++bj) {
                    f32x4 g0, g1; unpack8(gq[m][bj], g0, g1);
                    f32x4 v0 = g0 * acc[ai][bj][m][0], v1 = g1 * acc[ai][bj][m][1];
                    if (kind == 1) { f32x4 p0, p1; unpack8(pq[m][bj], p0, p1); v0 += p0; v1 += p1; }
                    *(u32x4*)((bf16_t*)MG + frag_off(u.pm * 8 + u.pn, ai, m, bj, wr, wc, fr, fq)) = pack8(v0, v1); }
        }
    }
};
}

template <int DEPTH>
__device__ __forceinline__ void cvt_item(const float* __restrict__ W, int N, bf16_t* D, int ldk, int k0, int n0, int drow0, LAS float* scr, int lane) {
    const float* src = W + (size_t)k0 * N + n0 + lane;
#pragma unroll
    for (int i0 = 0; i0 < 64; i0 += DEPTH) {
        float v[DEPTH];
#pragma unroll
        for (int d = 0; d < DEPTH; ++d) v[d] = __builtin_nontemporal_load(src + (size_t)(i0 + d) * N);
        __builtin_amdgcn_sched_barrier(0);
#pragma unroll
        for (int d = 0; d < DEPTH; ++d) scr[(i0 + d) * 65 + lane] = v[d];
    }
    LDS_WAIT();
    const int c = lane & 7;
#pragma unroll
    for (int j = 0; j < 8; ++j) { const int n = (lane >> 3) + 8 * j; const LAS float* s = scr + (8 * c) * 65 + n;
        u32x4 o; o.x = cvt_pk_bf16(s[0 * 65], s[1 * 65]); o.y = cvt_pk_bf16(s[2 * 65], s[3 * 65]); o.z = cvt_pk_bf16(s[4 * 65], s[5 * 65]); o.w = cvt_pk_bf16(s[6 * 65], s[7 * 65]);
        *(u32x4*)(D + (size_t)(drow0 + n) * ldk + k0 + 8 * c) = o; }
    LDS_WAIT();
}
template <int DEPTH = 16>
__device__ __forceinline__ bool cvt_mat(int& r, const float* W, int K, int N, bf16_t* D, int mode, int roff, LAS float* scr, int lane, int ldk = 0) {
    const int nb = N / 64, items = (K / 64) * nb;
    if (r >= items) { r -= items; return false; }
    const int nkb = K / 64; const int kb = r % nkb, n0 = (r / nkb) * 64;
    const int drow0 = mode ? ((n0 >> 7) * 256 + roff + (n0 & 127)) : (roff + n0);
    cvt_item<DEPTH>(W, N, D, ldk ? ldk : K, kb * 64, n0, drow0, scr, lane);
    return true;
}
__device__ __forceinline__ void rms_row_bf16(const float* xrow, const float* g, bf16_t* orow, int lane) {
    f32x4 v[8]; float s = 0.f;
#pragma unroll
    for (int j = 0; j < 8; ++j) { v[j] = *(const f32x4*)(xrow + 4 * lane + 256 * j); s += (v[j][0] * v[j][0] + v[j][1] * v[j][1]) + (v[j][2] * v[j][2] + v[j][3] * v[j][3]); }
    const float r = 1.0f / sqrtf(wave_sum(s) * (1.0f / DM) + RMS_EPS);
#pragma unroll
    for (int j = 0; j < 8; ++j) { const f32x4 gv = *(const f32x4*)(g + 4 * lane + 256 * j); const f32x4 o = v[j] * r * gv;
        u32x2 w; w.x = cvt_pk_bf16(o[0], o[1]); w.y = cvt_pk_bf16(o[2], o[3]); *(u32x2*)(orow + 4 * lane + 256 * j) = w; }
}
__device__ __forceinline__ const float* xrow_ptr(const float* xp, const float* xs, int m) { return m < MP ? xp + (size_t)m * DM : xs + (size_t)(m - MP) * DM; }

template <int MODE>
__device__ __forceinline__ void rowop(int gw, int ngw, int lane, const float* F, const float* SLAB, int nslab, const float* xp, const float* xs, float* H, const float* gpost, const float* gpre, bf16_t* XN, float* out) {
    for (int m = gw; m < MP; m += ngw) {
        const bf16_t* frow = (const bf16_t*)F + (size_t)m * DM; const float* brow = (MODE == 0) ? xrow_ptr(xp, xs, m) : nullptr; const bf16_t* hrow = (const bf16_t*)H + (size_t)m * DM;
        f32x4 f[8]; float s = 0.f;
        if (m < MP) {
#pragma unroll
            for (int j = 0; j < 8; ++j) { const u32x2 w = __builtin_nontemporal_load((const u32x2*)(frow + 4 * lane + 256 * j));
                f[j][0] = __uint_as_float(w.x << 16); f[j][1] = __uint_as_float(w.x & 0xffff0000u); f[j][2] = __uint_as_float(w.y << 16); f[j][3] = __uint_as_float(w.y & 0xffff0000u); }
        } else {
#pragma unroll
            for (int j = 0; j < 8; ++j) f[j] = (f32x4){0.f, 0.f, 0.f, 0.f};
            for (int k = 0; k < nslab; ++k) { const float* srow = SLAB + ((size_t)k * 128 + (m - MP)) * DM;
#pragma unroll
                for (int j = 0; j < 8; ++j) f[j] += *(const f32x4*)(srow + 4 * lane + 256 * j); }
        }
#pragma unroll
        for (int j = 0; j < 8; ++j) s += (f[j][0] * f[j][0] + f[j][1] * f[j][1]) + (f[j][2] * f[j][2] + f[j][3] * f[j][3]);
        const float r = ((MODE == 1) ? 1.0f : 0.5f) / sqrtf(wave_sum(s) * (1.0f / DM) + RMS_EPS);
        float s2 = 0.f;
#pragma unroll
        for (int j = 0; j < 8; ++j) { const f32x4 gv = *(const f32x4*)(gpost + 4 * lane + 256 * j); f32x4 bv; if (MODE == 0) bv = __builtin_nontemporal_load((const f32x4*)(brow + 4 * lane + 256 * j)); else { const u32x2 hw = __builtin_nontemporal_load((const u32x2*)(hrow + 4 * lane + 256 * j)); bv[0] = __uint_as_float(hw.x << 16); bv[1] = __uint_as_float(hw.x & 0xffff0000u); bv[2] = __uint_as_float(hw.y << 16); bv[3] = __uint_as_float(hw.y & 0xffff0000u); }
            f[j] = bv + f[j] * r * gv; s2 += (f[j][0] * f[j][0] + f[j][1] * f[j][1]) + (f[j][2] * f[j][2] + f[j][3] * f[j][3]); }
        if (MODE == 2) {
#pragma unroll
            for (int j = 0; j < 8; ++j) __builtin_nontemporal_store(f[j], (f32x4*)(out + (size_t)m * DM + 4 * lane + 256 * j));
        } else {
            const float r2 = 1.0f / sqrtf(wave_sum(s2) * (1.0f / DM) + RMS_EPS);
#pragma unroll
            for (int j = 0; j < 8; ++j) { { u32x2 hw; hw.x = cvt_pk_bf16(f[j][0], f[j][1]); hw.y = cvt_pk_bf16(f[j][2], f[j][3]); __builtin_nontemporal_store(hw, (u32x2*)((bf16_t*)H + (size_t)m * DM + 4 * lane + 256 * j)); }
                const f32x4 gv = *(const f32x4*)(gpre + 4 * lane + 256 * j); const f32x4 o = f[j] * r2 * gv;
                u32x2 w; w.x = cvt_pk_bf16(o[0], o[1]); w.y = cvt_pk_bf16(o[2], o[3]); *(u32x2*)(XN + (size_t)m * DM + 4 * lane + 256 * j) = w; }
        }
    }
}

__device__ __forceinline__ f32x4 bf4(const u32x2& w) { f32x4 r; r[0] = __uint_as_float(w.x << 16); r[1] = __uint_as_float(w.x & 0xffff0000u); r[2] = __uint_as_float(w.y << 16); r[3] = __uint_as_float(w.y & 0xffff0000u); return r; }
__device__ __forceinline__ f32x4 ld4bf(const bf16_t* p) { const u32x2 w = *(const u32x2*)p; f32x4 r; r[0] = __uint_as_float(w.x << 16); r[1] = __uint_as_float(w.x & 0xffff0000u); r[2] = __uint_as_float(w.y << 16); r[3] = __uint_as_float(w.y & 0xffff0000u); return r; }
template <int MODE>
__device__ __forceinline__ void rowop_sample(int bx, int G, int wave, int lane, LAS unsigned char* lds, const float* SLAB, int nslab, const float* xs, float* H, const float* gpost, const float* gpre, bf16_t* XN, float* out) {
    LAS float* red = (LAS float*)lds;
    for (int r = bx; r < MS; r += G) {
        const int m = MP + r, c = wave * 256 + 4 * lane;
        f32x4 f = (f32x4){0.f, 0.f, 0.f, 0.f};
        for (int k = 0; k < nslab; ++k) f += *(const f32x4*)(SLAB + ((size_t)k * 128 + r) * DM + c);
        float s = wave_sum((f[0] * f[0] + f[1] * f[1]) + (f[2] * f[2] + f[3] * f[3]));
        if (lane == 0) red[wave] = s;
        __syncthreads();
        s = ((red[0] + red[1]) + (red[2] + red[3])) + ((red[4] + red[5]) + (red[6] + red[7]));
        const float rr = ((MODE == 1) ? 1.0f : 0.5f) / sqrtf(s * (1.0f / DM) + RMS_EPS);
        f32x4 bv;
        if (MODE == 0) bv = *(const f32x4*)(xs + (size_t)r * DM + c);
        else { const u32x2 hw = *(const u32x2*)((const bf16_t*)H + (size_t)m * DM + c); bv[0] = __uint_as_float(hw.x << 16); bv[1] = __uint_as_float(hw.x & 0xffff0000u); bv[2] = __uint_as_float(hw.y << 16); bv[3] = __uint_as_float(hw.y & 0xffff0000u); }
        const f32x4 gv = *(const f32x4*)(gpost + c);
        f = bv + f * rr * gv;
        if (MODE == 2) { *(f32x4*)(out + (size_t)m * DM + c) = f; }
        else {
            float s2 = wave_sum((f[0] * f[0] + f[1] * f[1]) + (f[2] * f[2] + f[3] * f[3]));
            if (lane == 0) red[8 + wave] = s2;
            __syncthreads();
            s2 = ((red[8] + red[9]) + (red[10] + red[11])) + ((red[12] + red[13]) + (red[14] + red[15]));
            const float r2 = 1.0f / sqrtf(s2 * (1.0f / DM) + RMS_EPS);
            { u32x2 hw; hw.x = cvt_pk_bf16(f[0], f[1]); hw.y = cvt_pk_bf16(f[2], f[3]); *(u32x2*)((bf16_t*)H + (size_t)m * DM + c) = hw; }
            const f32x4 gp = *(const f32x4*)(gpre + c); const f32x4 o = f * r2 * gp;
            u32x2 w; w.x = cvt_pk_bf16(o[0], o[1]); w.y = cvt_pk_bf16(o[2], o[3]); *(u32x2*)(XN + (size_t)m * DM + c) = w;
        }
        __syncthreads();
    }
}

constexpr int POOL_NCHUNK = 2048 + 512 + 240 + 960;
template <int W>
__device__ __forceinline__ void pool_item(const bf16_t* __restrict__ UP, bf16_t* __restrict__ DIFF, int m0, int t0, int c) {
    const bf16_t* base = UP + (size_t)m0 * PW + c;
    const bool first = (t0 == 0);
    u32x2 r[W + 15];
#pragma unroll
    for (int k = 0; k < W + 15; ++k) { const int dt = k - (W - 1); const bf16_t* a = (dt < 0 && first) ? base : base + (long)dt * PW; r[k] = *(const u32x2*)a; }
    __builtin_amdgcn_sched_barrier(0);
    if (first) {
#pragma unroll
        for (int k = 0; k < W - 1; ++k) r[k] = (u32x2){0u, 0u};
    }
    f32x4 sum = (f32x4){0.f, 0.f, 0.f, 0.f};
#pragma unroll
    for (int s = 1; s < W; ++s) sum += bf4(r[W - 1 - s]);
#pragma unroll
    for (int i = 0; i < 16; ++i) {
        const f32x4 uv = bf4(r[W - 1 + i]);
        sum += uv;
        const int t = t0 + i, cnt = (t + 1) < W ? (t + 1) : W;
        const f32x4 d = sum / (float)cnt - uv;
        u32x2 o; o.x = cvt_pk_bf16(d[0], d[1]); o.y = cvt_pk_bf16(d[2], d[3]); *(u32x2*)(DIFF + (size_t)(m0 + i) * PW + c) = o;
        sum -= bf4(r[i]);
    }
}
__device__ __forceinline__ void pool_chunk(int q, int lane, const float* UPf, const float* spool, bf16_t* DIFF, float* out_pp, float* out_ps) {
    const bf16_t* UP = (const bf16_t*)UPf;
    if (q < 2048) {
        const int idx = q * 64 + lane;
        const int c = (idx & 255) * 4, ch = idx >> 8, m0 = ch * 16, t0 = m0 & (SEQ - 1), grp = q & 3;
        if (grp == 0) pool_item<2>(UP, DIFF, m0, t0, c);
        else if (grp == 1) pool_item<4>(UP, DIFF, m0, t0, c);
        else if (grp == 2) pool_item<8>(UP, DIFF, m0, t0, c);
        else pool_item<16>(UP, DIFF, m0, t0, c);
    } else if (q < 2560) {
        const int idx = (q - 2048) * 64 + lane;
        const int c = (idx & 255) * 4, b = idx >> 8, w = 2 << (c >> 8);
        const f32x4 uv = ld4bf(UP + (size_t)(MP + b) * PW + c);
        f32x4 sum = uv;
        for (int e = 16 - w; e < 15; ++e) sum += *(const f32x4*)(spool + ((size_t)b * 15 + e) * PW + c);
        const f32x4 d = sum / (float)w - uv;
        u32x2 o; o.x = cvt_pk_bf16(d[0], d[1]); o.y = cvt_pk_bf16(d[2], d[3]); *(u32x2*)(DIFF + (size_t)(MP + b) * PW + c) = o;
    } else if (q < 2800) {
        const int idx = (q - 2560) * 64 + lane; const int c = (idx & 255) * 4, e = (idx >> 8) % 15, b = (idx >> 8) / 15;
        *(f32x4*)(out_pp + ((size_t)b * 15 + e) * PW + c) = ld4bf(UP + ((size_t)b * SEQ + (SEQ - 15) + e) * PW + c);
    } else {
        f32x4 v[8];
#pragma unroll
        for (int j = 0; j < 8; ++j) { const int idx = ((q - 2800) * 8 + j) * 64 + lane; const int c = (idx & 255) * 4, e = (idx >> 8) % 15, b = (idx >> 8) / 15;
            v[j] = (e < 14) ? *(const f32x4*)(spool + ((size_t)b * 15 + e + 1) * PW + c) : ld4bf(UP + (size_t)(MP + b) * PW + c); }
        __builtin_amdgcn_sched_barrier(0);
#pragma unroll
        for (int j = 0; j < 8; ++j) { const int idx = ((q - 2800) * 8 + j) * 64 + lane; const int c = (idx & 255) * 4, e = (idx >> 8) % 15, b = (idx >> 8) / 15;
            *(f32x4*)(out_ps + ((size_t)b * 15 + e) * PW + c) = v[j]; }
    }
}
__device__ __forceinline__ void pool_steal(int bx, int G, LAS unsigned* counter, int lane, const float* UPf, const float* spool, bf16_t* DIFF, float* out_pp, float* out_ps) {
    for (;;) {
        unsigned n = 0;
        if (lane == 0) n = __hip_atomic_fetch_add(counter, 1u, __ATOMIC_RELAXED, __HIP_MEMORY_SCOPE_WORKGROUP);
        n = (unsigned)__builtin_amdgcn_readfirstlane((int)n);
        const int q = bx + (int)n * G;
        if (q >= POOL_NCHUNK) break;
        pool_chunk(q, lane, UPf, spool, DIFF, out_pp, out_ps);
    }
}

__device__ __forceinline__ double dexp_small(double x) {
    const double z = x * (1.0 / 256.0); double term = 1.0, e = 1.0;
#pragma unroll
    for (int k = 1; k <= 12; ++k) { term *= z / (double)k; e += term; }
#pragma unroll
    for (int k = 0; k < 8; ++k) e = e * e;
    return e;
}
__device__ __forceinline__ void ssm_params(int g, int n, const float* a_re, const float* a_im, const float* log_step, const float* b_re, const float* b_im,
                                           float& lr, float& li, float& pr, float& pi, float (&bbr)[16], float (&bbi)[16], int nsq = 8) {
    const double dt = dexp_small((double)log_step[g]);
    const double ar = (double)a_re[g * 64 + n], ai = (double)a_im[g * 64 + n];
    const double mag = dexp_small(ar * dt);
    const double ang = ai * dt; const double TWO_PI = 6.283185307179586476925;
    const double r = ang - rint(ang / TWO_PI) * TWO_PI, r2 = r * r;
    double sn = r, cs = 1.0, ts = r, tc = 1.0;
#pragma unroll
    for (int k = 1; k <= 14; ++k) { tc *= -r2 / (double)((2 * k - 1) * (2 * k)); cs += tc; ts *= -r2 / (double)((2 * k) * (2 * k + 1)); sn += ts; }
    const double lbr = mag * cs, lbi = mag * sn;
    const double den = ar * ar + ai * ai, nre = lbr - 1.0;
    const double fre = (nre * ar + lbi * ai) / den, fim = (lbi * ar - nre * ai) / den;
    lr = (float)lbr; li = (float)lbi;
    double qr = lbr, qi = lbi;
#pragma unroll
    for (int k = 0; k < nsq; ++k) { const double t = qr * qr - qi * qi; qi = 2.0 * qr * qi; qr = t; }
    pr = (float)qr; pi = (float)qi;
    const float* br = b_re + (size_t)(g * 64 + n) * 16; const float* bi = b_im + (size_t)(g * 64 + n) * 16;
#pragma unroll
    for (int h4 = 0; h4 < 4; ++h4) { const f32x4 x = *(const f32x4*)(br + 4 * h4), y = *(const f32x4*)(bi + 4 * h4);
#pragma unroll
        for (int j = 0; j < 4; ++j) { bbr[4 * h4 + j] = (float)(fre * (double)x[j] - fim * (double)y[j]); bbi[4 * h4 + j] = (float)(fre * (double)y[j] + fim * (double)x[j]); } }
}
__device__ __forceinline__ void ssm_cfrag(int g, int lane, const float* c_re, const float* c_im, bf16x8 (&cf)[4]) {
    const int h = lane & 15, q4 = lane >> 4;
#pragma unroll
    for (int ks = 0; ks < 4; ++ks) {
        const f32x4 cr = *(const f32x4*)(c_re + (size_t)(g * 16 + h) * 64 + 16 * ks + 4 * q4), ci = *(const f32x4*)(c_im + (size_t)(g * 16 + h) * 64 + 16 * ks + 4 * q4);
        u32x4 w; w.x = cvt_pk_bf16(cr[0], -ci[0]); w.y = cvt_pk_bf16(cr[1], -ci[1]); w.z = cvt_pk_bf16(cr[2], -ci[2]); w.w = cvt_pk_bf16(cr[3], -ci[3]);
        cf[ks] = __builtin_bit_cast(bf16x8, w);
    }
}
constexpr int SSM_WSTRIDE = 23040;
#define SSM_STEP(UPTR) do { const f32x4 _u0 = *(const LAS f32x4*)(UPTR), _u1 = *(const LAS f32x4*)((UPTR) + 4), _u2 = *(const LAS f32x4*)((UPTR) + 8), _u3 = *(const LAS f32x4*)((UPTR) + 12); \
        float _r0 = bbr[0] * _u0[0], _r1 = bbr[1] * _u0[1], _i0 = bbi[0] * _u0[0], _i1 = bbi[1] * _u0[1]; \
        _r0 = fmaf(bbr[2], _u0[2], _r0); _r1 = fmaf(bbr[3], _u0[3], _r1); _i0 = fmaf(bbi[2], _u0[2], _i0); _i1 = fmaf(bbi[3], _u0[3], _i1); \
        _r0 = fmaf(bbr[4], _u1[0], _r0); _r1 = fmaf(bbr[5], _u1[1], _r1); _i0 = fmaf(bbi[4], _u1[0], _i0); _i1 = fmaf(bbi[5], _u1[1], _i1); \
        _r0 = fmaf(bbr[6], _u1[2], _r0); _r1 = fmaf(bbr[7], _u1[3], _r1); _i0 = fmaf(bbi[6], _u1[2], _i0); _i1 = fmaf(bbi[7], _u1[3], _i1); \
        _r0 = fmaf(bbr[8], _u2[0], _r0); _r1 = fmaf(bbr[9], _u2[1], _r1); _i0 = fmaf(bbi[8], _u2[0], _i0); _i1 = fmaf(bbi[9], _u2[1], _i1); \
        _r0 = fmaf(bbr[10], _u2[2], _r0); _r1 = fmaf(bbr[11], _u2[3], _r1); _i0 = fmaf(bbi[10], _u2[2], _i0); _i1 = fmaf(bbi[11], _u2[3], _i1); \
        _r0 = fmaf(bbr[12], _u3[0], _r0); _r1 = fmaf(bbr[13], _u3[1], _r1); _i0 = fmaf(bbi[12], _u3[0], _i0); _i1 = fmaf(bbi[13], _u3[1], _i1); \
        _r0 = fmaf(bbr[14], _u3[2], _r0); _r1 = fmaf(bbr[15], _u3[3], _r1); _i0 = fmaf(bbi[14], _u3[2], _i0); _i1 = fmaf(bbi[15], _u3[3], _i1); \
        const float _nr = fmaf(lr, xr, fmaf(-li, xi, _r0 + _r1)), _ni = fmaf(lr, xi, fmaf(li, xr, _i0 + _i1)); xr = _nr; xi = _ni; } while (0)

constexpr int SSM_NW = 4, SSM_CH = SEQ / SSM_NW, SSM_SUBS = SSM_CH / 64;
__device__ __forceinline__ void ssm_prompt_unit(int b, int g, const float* US, bf16_t* GS, float* out_re, float* out_im, const float* const* in, LAS unsigned char* lds, volatile LAS unsigned* flags, unsigned epoch, int wave, int lane) {
    float lr, li, pr, pi;
    LAS float* ub = (LAS float*)(lds + wave * SSM_WSTRIDE);
    LAS unsigned* xt = (LAS unsigned*)(lds + wave * SSM_WSTRIDE + 8192);
    LAS float* but = (LAS float*)(lds + wave * SSM_WSTRIDE + 12544);
    volatile LAS float* sb = (volatile LAS float*)(lds + SSM_NW * SSM_WSTRIDE);
    const int l15 = lane & 15, q4 = lane >> 4;
    bf16x8 bfr[8];
    {
        float bbr[16], bbi[16];
        ssm_params(g, lane, in[I_ARE], in[I_AIM], in[I_LOGSTEP], in[I_BRE], in[I_BIM], lr, li, pr, pi, bbr, bbi, 9);
        LAS unsigned* tb = (LAS unsigned*)but;
#pragma unroll
        for (int k = 0; k < 8; ++k) { tb[lane * 8 + k] = cvt_pk_bf16(bbr[2 * k], bbr[2 * k + 1]); tb[(64 + lane) * 8 + k] = cvt_pk_bf16(bbi[2 * k], bbi[2 * k + 1]); }
        LDS_WAIT();
#pragma unroll
        for (int nb = 0; nb < 8; ++nb) { u32x4 w = (u32x4){0u, 0u, 0u, 0u}; if (q4 < 2) w = *(const LAS u32x4*)(tb + (16 * nb + l15) * 8 + 4 * q4); bfr[nb] = __builtin_bit_cast(bf16x8, w); }
        LDS_WAIT();
    }
    const size_t row0 = (size_t)b * SEQ + (size_t)wave * SSM_CH;
    const bf16_t* up = (const bf16_t*)US + us_off(row0, g * 16);
    u32x2 pk[SSM_SUBS][4];
#pragma unroll
    for (int _s = 0; _s < SSM_SUBS; ++_s)
#pragma unroll
        for (int _i = 0; _i < 4; ++_i) { const int _p = _i * 64 + lane; pk[_s][_i] = *(const u32x2*)(up + (size_t)(_s * 64 + (_p >> 2)) * 16 + (_p & 3) * 4); }
#define SSM_STOREU(buf, sub) do { _Pragma("unroll") for (int _i = 0; _i < 4; ++_i) *(LAS f32x4*)(ub + (buf) * 1024 + (_i * 64 + lane) * 4) = bf4(pk[sub][_i]); } while (0)
#define SSM_TILE_BU(UT) \
        f32x4 bre[4], bim[4]; \
        { u32x4 uw = (u32x4){0u, 0u, 0u, 0u}; \
          if (q4 < 2) { const f32x4 ua = *(const LAS f32x4*)((UT) + l15 * 16 + 8 * q4), ubv = *(const LAS f32x4*)((UT) + l15 * 16 + 8 * q4 + 4); \
              uw.x = cvt_pk_bf16(ua[0], ua[1]); uw.y = cvt_pk_bf16(ua[2], ua[3]); uw.z = cvt_pk_bf16(ubv[0], ubv[1]); uw.w = cvt_pk_bf16(ubv[2], ubv[3]); } \
          const bf16x8 uf = __builtin_bit_cast(bf16x8, uw); \
          _Pragma("unroll") for (int nb = 0; nb < 8; ++nb) { const f32x4 d = __builtin_amdgcn_mfma_f32_16x16x32_bf16(uf, bfr[nb], (f32x4){0.f, 0.f, 0.f, 0.f}, 0, 0, 0); \
              *(LAS f32x4*)(but + (16 * nb + l15) * 20 + 4 * q4) = d; } \
          _Pragma("unroll") for (int k = 0; k < 4; ++k) { bre[k] = *(const LAS f32x4*)(but + lane * 20 + 4 * k); bim[k] = *(const LAS f32x4*)(but + (64 + lane) * 20 + 4 * k); } }
#define SSM_UPD(tt) do { const float _br = bre[(tt) >> 2][(tt) & 3], _bi = bim[(tt) >> 2][(tt) & 3]; \
        const float _nr = fmaf(lr, xr, fmaf(-li, xi, _br)), _ni = fmaf(lr, xi, fmaf(li, xr, _bi)); xr = _nr; xi = _ni; } while (0)
    float xr = 0.f, xi = 0.f;
    SSM_STOREU(0, 0);
#pragma unroll
    for (int sub = 0; sub < SSM_SUBS; ++sub) {
        const LAS float* u = ub + (sub & 1) * 1024;
        if (sub < SSM_SUBS - 1) SSM_STOREU((sub + 1) & 1, sub + 1);
_Pragma("unroll 1")
        for (int tile = 0; tile < 4; ++tile) {
            SSM_TILE_BU(u + tile * 256);
#pragma unroll
            for (int tt = 0; tt < 16; ++tt) SSM_UPD(tt);
        }
    }
    if (epoch > 1u) for (int j = 0; j < SSM_NW; ++j) while (flags[4 + j] != epoch - 1u) __builtin_amdgcn_s_sleep(1);
    sb[(wave * 64 + lane) * 2] = xr; sb[(wave * 64 + lane) * 2 + 1] = xi;
    LDS_WAIT();
    __builtin_amdgcn_fence(__ATOMIC_RELEASE, "workgroup");
    if (lane == 0) flags[wave] = epoch;
    float cr = 0.f, ci = 0.f;
    for (int j = 0; j < wave; ++j) {
        while (flags[j] != epoch) __builtin_amdgcn_s_sleep(1);
        __builtin_amdgcn_fence(__ATOMIC_ACQUIRE, "workgroup");
        const float sr = sb[(j * 64 + lane) * 2], si = sb[(j * 64 + lane) * 2 + 1];
        const float nr = pr * cr - pi * ci + sr, ni = pr * ci + pi * cr + si; cr = nr; ci = ni; }
    if (lane == 0) flags[4 + wave] = epoch;
    bf16x8 cf[4]; ssm_cfrag(g, lane, in[I_CRE], in[I_CIM], cf);
    const int h = l15, tq = q4;
    const float dsk = in[I_SSMD][g * 16 + h];
    xr = cr; xi = ci;
    SSM_STOREU(0, 0);
#pragma unroll
    for (int sub = 0; sub < SSM_SUBS; ++sub) {
        const LAS float* u = ub + (sub & 1) * 1024;
        if (sub < SSM_SUBS - 1) SSM_STOREU((sub + 1) & 1, sub + 1);
_Pragma("unroll 1")
        for (int tile = 0; tile < 4; ++tile) {
            SSM_TILE_BU(u + tile * 256);
#pragma unroll
            for (int tt = 0; tt < 16; ++tt) { SSM_UPD(tt); xt[tt * 68 + lane] = cvt_pk_bf16(xr, xi); }
            f32x4 acc = (f32x4){0.f, 0.f, 0.f, 0.f};
#pragma unroll
            for (int ks = 0; ks < 4; ++ks) { const bf16x8 a = *(const LAS bf16x8*)(xt + h * 68 + 4 * tq + 16 * ks); acc = __builtin_amdgcn_mfma_f32_16x16x32_bf16(a, cf[ks], acc, 0, 0, 0); }
#pragma unroll
            for (int r = 0; r < 4; ++r) { const int tl = tile * 16 + 4 * tq + r; const float y = acc[r] + dsk * u[tl * 16 + h];
                GS[(row0 + sub * 64 + tl) * 1024 + g * 16 + h] = (bf16_t)(cvt_pk_bf16(gelu_tanh(y), 0.f) & 0xffff); }
        }
    }
    if (wave == SSM_NW - 1) { out_re[(size_t)(b * 64 + g) * 64 + lane] = xr; out_im[(size_t)(b * 64 + g) * 64 + lane] = xi; }
#undef SSM_STOREU
#undef SSM_TILE_BU
#undef SSM_UPD
}
__device__ __forceinline__ void ssm_sample_unit(int g, int bq, const float* US, bf16_t* GS, const float* st_re, const float* st_im, float* out_re, float* out_im, const float* const* in,
                                                LAS unsigned char* lds, int wave, int lane) {
    float lr, li, pr, pi; float bbr[16], bbi[16];
    ssm_params(g, lane, in[I_ARE], in[I_AIM], in[I_LOGSTEP], in[I_BRE], in[I_BIM], lr, li, pr, pi, bbr, bbi);
    LAS float* ub = (LAS float*)(lds + wave * SSM_WSTRIDE);
    LAS unsigned* xt = (LAS unsigned*)(lds + wave * SSM_WSTRIDE + 8192);
    { const int i = lane >> 2, part = lane & 3; *(LAS f32x4*)(ub + lane * 4) = ld4bf((const bf16_t*)US + us_off((size_t)(MP + bq * 16 + i), g * 16 + part * 4)); }
    for (int i = 0; i < 16; ++i) {
        const int b = bq * 16 + i; const size_t so = (size_t)(b * 64 + g) * 64 + lane;
        float xr = st_re[so], xi = st_im[so];
        SSM_STEP(ub + i * 16);
        out_re[so] = xr; out_im[so] = xi;
        xt[i * 68 + lane] = cvt_pk_bf16(xr, xi);
    }
    bf16x8 cf[4]; ssm_cfrag(g, lane, in[I_CRE], in[I_CIM], cf);
    const int h = lane & 15, tq = lane >> 4;
    const float dsk = in[I_SSMD][g * 16 + h];
    f32x4 acc = (f32x4){0.f, 0.f, 0.f, 0.f};
#pragma unroll
    for (int ks = 0; ks < 4; ++ks) { const bf16x8 a = *(const LAS bf16x8*)(xt + h * 68 + 4 * tq + 16 * ks); acc = __builtin_amdgcn_mfma_f32_16x16x32_bf16(a, cf[ks], acc, 0, 0, 0); }
#pragma unroll
    for (int r = 0; r < 4; ++r) { const int i = 4 * tq + r; const float y = acc[r] + dsk * ub[i * 16 + h];
        GS[(size_t)(MP + bq * 16 + i) * 1024 + g * 16 + h] = (bf16_t)(cvt_pk_bf16(gelu_tanh(y), 0.f) & 0xffff); }
}

__device__ __forceinline__ void attn_load_img(LAS unsigned char* img, const bf16_t* base, int row_stride, int tid) {
#pragma unroll 4
    for (int it = 0; it < 16; ++it) { const int cidx = it * NTHREADS + tid, row = cidx >> 5, c16 = cidx & 31;
        const u32x4 v = *(const u32x4*)(base + (size_t)row * row_stride + c16 * 8);
        *(LAS u32x4*)(img + row * 512 + ((c16 ^ (row & 15)) << 4)) = v; }
}
__device__ __forceinline__ void attn_prompt_unit(int b, int hd, int qb, const bf16_t* Q, const bf16_t* KB, const bf16_t* VT, bf16_t* XO, LAS unsigned char* lds, int tid, int wave, int lane) {
    const int l15 = lane & 15, h4 = lane >> 4;
    const size_t qrow = (size_t)b * SEQ + qb * 128 + wave * 16 + l15;
    bf16x8 qf[8];
#pragma unroll
    for (int ks = 0; ks < 8; ++ks) qf[ks] = *(const bf16x8*)(Q + qrow * 1024 + hd * 256 + 32 * ks + 8 * h4);
    attn_load_img(lds, KB + (size_t)b * NMEM * 1024 + hd * 256, 1024, tid);
    __syncthreads();
    f32x4 sa[16];
#pragma unroll
    for (int nb = 0; nb < 16; ++nb) {
        f32x4 acc = (f32x4){0.f, 0.f, 0.f, 0.f};
#pragma unroll
        for (int ks = 0; ks < 8; ++ks) { const bf16x8 a = *(const LAS bf16x8*)(lds + (16 * nb + l15) * 512 + (((4 * ks + h4) ^ l15) << 4));
            acc = __builtin_amdgcn_mfma_f32_16x16x32_bf16(a, qf[ks], acc, 0, 0, 0); }
        sa[nb] = acc;
    }
    float mx = -3.0e38f;
#pragma unroll
    for (int nb = 0; nb < 16; ++nb) mx = fmaxf(fmaxf(mx, fmaxf(sa[nb][0], sa[nb][1])), fmaxf(sa[nb][2], sa[nb][3]));
    mx = fmaxf(mx, __shfl_xor(mx, 16)); mx = fmaxf(mx, __shfl_xor(mx, 32));
    float sum = 0.f;
#pragma unroll
    for (int nb = 0; nb < 16; ++nb) {
#pragma unroll
        for (int r = 0; r < 4; ++r) { const float p = __expf(sa[nb][r] - mx); sa[nb][r] = p; sum += p; } }
    sum += __shfl_xor(sum, 16); sum += __shfl_xor(sum, 32);
    const float inv = 1.0f / sum;
    bf16x8 pf[8];
#pragma unroll
    for (int ks = 0; ks < 8; ++ks) { u32x4 w; w.x = cvt_pk_bf16(sa[2 * ks][0], sa[2 * ks][1]); w.y = cvt_pk_bf16(sa[2 * ks][2], sa[2 * ks][3]);
        w.z = cvt_pk_bf16(sa[2 * ks + 1][0], sa[2 * ks + 1][1]); w.w = cvt_pk_bf16(sa[2 * ks + 1][2], sa[2 * ks + 1][3]); pf[ks] = __builtin_bit_cast(bf16x8, w); }
    __syncthreads();
    attn_load_img(lds, VT + (size_t)(b * 4 + hd) * 256 * 256, 256, tid);
    __syncthreads();
#pragma unroll
    for (int db = 0; db < 16; ++db) {
        f32x4 acc = (f32x4){0.f, 0.f, 0.f, 0.f};
#pragma unroll
        for (int ks = 0; ks < 8; ++ks) {
            const LAS unsigned char* rp = lds + (16 * db + l15) * 512;
            const u32x2 lo = *(const LAS u32x2*)(rp + (((8 * ks + h4) ^ (l15 << 1)) << 3)), hi = *(const LAS u32x2*)(rp + (((8 * ks + 4 + h4) ^ (l15 << 1)) << 3));
            u32x4 w; w.x = lo.x; w.y = lo.y; w.z = hi.x; w.w = hi.y;
            acc = __builtin_amdgcn_mfma_f32_16x16x32_bf16(__builtin_bit_cast(bf16x8, w), pf[ks], acc, 0, 0, 0);
        }
        u32x2 o; o.x = cvt_pk_bf16(acc[0] * inv, acc[1] * inv); o.y = cvt_pk_bf16(acc[2] * inv, acc[3] * inv);
        *(u32x2*)(XO + qrow * 1024 + hd * 256 + 16 * db + 4 * h4) = o;
    }
    __syncthreads();
}
__device__ __forceinline__ float red16(float (&p)[16], int lane) {
#pragma unroll
    for (int k = 0; k < 8; ++k) { const float a = p[k], b = p[k + 8]; const float snd = (lane & 32) ? a : b, keep = (lane & 32) ? b : a; p[k] = keep + __shfl_xor(snd, 32); }
#pragma unroll
    for (int k = 0; k < 4; ++k) { const float a = p[k], b = p[k + 4]; const float snd = (lane & 16) ? a : b, keep = (lane & 16) ? b : a; p[k] = keep + __shfl_xor(snd, 16); }
#pragma unroll
    for (int k = 0; k < 2; ++k) { const float a = p[k], b = p[k + 2]; const float snd = (lane & 8) ? a : b, keep = (lane & 8) ? b : a; p[k] = keep + __shfl_xor(snd, 8); }
    { const float a = p[0], b = p[1]; const float snd = (lane & 4) ? a : b, keep = (lane & 4) ? b : a; p[0] = keep + __shfl_xor(snd, 4); }
    float r = p[0]; r += __shfl_xor(r, 2); r += __shfl_xor(r, 1);
    return r;
}
__device__ __forceinline__ void attn_sample_half(int b, int hd, int kh, int rot, const bf16_t* Q, const float* CK, const float* CV, bf16_t* XO, LAS float* xch, volatile LAS unsigned* flag, unsigned epoch, int lane) {
    f32x4 q4; { const u32x2 qv = *(const u32x2*)(Q + (size_t)(MP + b) * 1024 + hd * 256 + 4 * lane);
        q4[0] = __uint_as_float(qv.x << 16); q4[1] = __uint_as_float(qv.x & 0xffff0000u); q4[2] = __uint_as_float(qv.y << 16); q4[3] = __uint_as_float(qv.y & 0xffff0000u); }
    const float* kbase = CK + ((size_t)b * NMEM * 4 + hd) * 256 + 4 * lane + (size_t)(kh * 128) * 1024;
    const float* vbase = CV + ((size_t)b * NMEM * 4 + hd) * 256 + 4 * lane + (size_t)(kh * 128) * 1024;
    float sc[8];
#pragma unroll
    for (int i = 0; i < 8; ++i) {
        const int bt = (i + rot) & 7;
        f32x4 kv[16];
#pragma unroll
        for (int j = 0; j < 16; ++j) kv[j] = __builtin_nontemporal_load((const f32x4*)(kbase + (size_t)(bt * 16 + j) * 1024));
        float p[16];
#pragma unroll
        for (int j = 0; j < 16; ++j) p[j] = (kv[j][0] * q4[0] + kv[j][1] * q4[1]) + (kv[j][2] * q4[2] + kv[j][3] * q4[3]);
        sc[i] = red16(p, lane);
    }
    float mx = sc[0];
#pragma unroll
    for (int i = 1; i < 8; ++i) mx = fmaxf(mx, sc[i]);
    mx = wave_max(mx);
    float sum = 0.f;
#pragma unroll
    for (int i = 0; i < 8; ++i) { sc[i] = __expf(sc[i] - mx); sum += sc[i]; }
    sum = wave_sum(sum) * 0.25f;
    f32x4 o = (f32x4){0.f, 0.f, 0.f, 0.f};
#pragma unroll
    for (int i = 0; i < 8; ++i) {
        const int bt = (i + rot) & 7;
        f32x4 vv[16];
#pragma unroll
        for (int j = 0; j < 16; ++j) vv[j] = __builtin_nontemporal_load((const f32x4*)(vbase + (size_t)(bt * 16 + j) * 1024));
#pragma unroll
        for (int j = 0; j < 16; ++j) { const float pj = __shfl(sc[i], 4 * j); o += vv[j] * pj; }
    }
    if (kh == 1) {
        if (epoch > 1u) while (flag[4] != epoch - 1u) __builtin_amdgcn_s_sleep(1);
        *(LAS f32x4*)(xch + 4 * lane) = o; if (lane == 0) { xch[256] = mx; xch[257] = sum; }
        LDS_WAIT();
        __builtin_amdgcn_fence(__ATOMIC_RELEASE, "workgroup");
        if (lane == 0) *flag = epoch;
    } else {
        while (*flag != epoch) __builtin_amdgcn_s_sleep(1);
        __builtin_amdgcn_fence(__ATOMIC_ACQUIRE, "workgroup");
        const volatile LAS float* xv = xch;
        const float mB = xv[256], lB = xv[257];
        f32x4 oB; oB[0] = xv[4 * lane]; oB[1] = xv[4 * lane + 1]; oB[2] = xv[4 * lane + 2]; oB[3] = xv[4 * lane + 3];
        const float M = fmaxf(mx, mB), fa = __expf(mx - M), fb = __expf(mB - M);
        const float inv = 1.0f / (sum * fa + lB * fb);
        o = (o * fa + oB * fb) * inv;
        u32x2 w; w.x = cvt_pk_bf16(o[0], o[1]); w.y = cvt_pk_bf16(o[2], o[3]);
        *(u32x2*)(XO + (size_t)(MP + b) * 1024 + hd * 256 + 4 * lane) = w;
        if (lane == 0) flag[4] = epoch;
    }
}

#define XB_TMO      128
#define XB_XCNT(j)  (256  + 64 * (j))
#define XB_XSUB(j)  (1280 + 64 * (j))
#define XB_XGEN(j)  (2304 + 64 * (j))
#define XB_TOP      3328
#define XB_TOPGEN   3392
#define XCD_BAR_WORDS 3456
#define XB_SPIN_CAP (1u << 18)
__device__ __forceinline__ unsigned xb_ld(unsigned* p)              { return __hip_atomic_load(p, __ATOMIC_RELAXED, __HIP_MEMORY_SCOPE_AGENT); }
__device__ __forceinline__ unsigned xb_add(unsigned* p, unsigned v) { return __hip_atomic_fetch_add(p, v, __ATOMIC_RELAXED, __HIP_MEMORY_SCOPE_AGENT); }
__device__ __forceinline__ unsigned xb_xcc_id() { return (unsigned)__builtin_amdgcn_s_getreg((3 << 11) | 20) & 0xFu; }
#define XB_SPIN(cond, bar) do { unsigned _sp = 0; while (cond) { __builtin_amdgcn_s_sleep(1); \
    if ((++_sp & 255u) == 0u) { if (xb_ld(&(bar)[XB_TMO])) break; if (_sp > XB_SPIN_CAP) { atomicAdd(&(bar)[XB_TMO], 1u); break; } } } } while (0)
struct XcdBarrier { unsigned* bar; unsigned x; volatile LAS unsigned* st; };
__device__ __forceinline__ XcdBarrier xcd_barrier_post(unsigned* bar, volatile LAS unsigned* st) {
    XcdBarrier b; b.bar = bar; b.x = xb_xcc_id(); b.st = st;
    if (threadIdx.x == 0) (void)xb_add(&bar[XB_XCNT(b.x)], 1u);
    return b;
}
__device__ __forceinline__ void xcd_barrier_complete(unsigned* bar, unsigned x, unsigned& nloc, unsigned& nx) {
    const unsigned G = gridDim.x * gridDim.y * gridDim.z;
    unsigned sum, cnt, mine, sp = 0u;
    for (;;) {
        sum = 0u; cnt = 0u; mine = 0u;
#pragma unroll
        for (unsigned j = 0; j < 16; ++j) { const unsigned c = xb_ld(&bar[XB_XCNT(j)]); sum += c; cnt += (c > 0u) ? 1u : 0u; mine = (j == x) ? c : mine; }
        if (sum == G) break;
        __builtin_amdgcn_s_sleep(1);
        if ((++sp & 255u) == 0u) { if (xb_ld(&bar[XB_TMO])) break; if (sp > XB_SPIN_CAP) { atomicAdd(&bar[XB_TMO], 1u); break; } }
    }
    nloc = mine > 0u ? mine : 1u; nx = cnt > 0u ? cnt : 1u;
}
__device__ __forceinline__ void xcd_barrier(const XcdBarrier& b) {
    asm volatile("s_waitcnt vmcnt(0)" ::: "memory");
    __syncthreads();
    if (threadIdx.x == 0) {
        unsigned* bar = b.bar;
        __builtin_amdgcn_s_waitcnt(0);
        unsigned nloc = b.st[0], nx = b.st[1];
        if (nloc == 0u) { xcd_barrier_complete(bar, b.x, nloc, nx); b.st[0] = nloc; b.st[1] = nx; }
        const unsigned old = xb_add(&bar[XB_XSUB(b.x)], 1u);
        const unsigned gen = old / nloc;
        if (old + 1u == (gen + 1u) * nloc) {
            __builtin_amdgcn_fence(__ATOMIC_RELEASE, "agent");
            asm volatile("s_waitcnt vmcnt(0)" ::: "memory");
            const unsigned og = xb_add(&bar[XB_TOP], 1u);
            const unsigned tg = og / nx;
            if (og + 1u == (tg + 1u) * nx) xb_add(&bar[XB_TOPGEN], 1u);
            else XB_SPIN(xb_ld(&bar[XB_TOPGEN]) == tg, bar);
            xb_add(&bar[XB_XGEN(b.x)], 1u);
            __builtin_amdgcn_fence(__ATOMIC_ACQUIRE, "agent");
            asm volatile("s_waitcnt vmcnt(0)" ::: "memory");
        } else {
            asm volatile("buffer_inv sc1" ::: "memory");
            XB_SPIN(xb_ld(&bar[XB_XGEN(b.x)]) == gen, bar);
            asm volatile("s_waitcnt vmcnt(0)" ::: "memory");
        }
    }
    __syncthreads();
}
constexpr int MISC_OFF = LDS_BYTES - 128;
constexpr size_t CTL_ZERO_BYTES = 65536;
constexpr int CW_BAR = 1024;

__global__ void __launch_bounds__(NTHREADS, 2) mk_fwd(Args args) {
    extern __shared__ __attribute__((aligned(16))) unsigned char lds_raw[];
    LAS unsigned char* lds = (LAS unsigned char*)lds_raw;
    const int tid = threadIdx.x, lane = tid & 63, wave = __builtin_amdgcn_readfirstlane(tid >> 6);
    const int G = gridDim.x, bx = blockIdx.x;
    const int gw = bx * NWAVES + wave, ngw = G * NWAVES;
    const int gtid = bx * NTHREADS + tid, ngt = G * NTHREADS;
    unsigned char* ws = args.ws;
    const float* const* in = args.in;
    float* out = args.out;
    bf16_t* W1GU = (bf16_t*)(ws + WS_W1GU); bf16_t* W1D = (bf16_t*)(ws + WS_W1D); bf16_t* WIN = (bf16_t*)(ws + WS_WIN); bf16_t* WPG = (bf16_t*)(ws + WS_WPG);
    bf16_t* WPO = (bf16_t*)(ws + WS_WPO); bf16_t* WGLU = (bf16_t*)(ws + WS_WGLU); bf16_t* WXO = (bf16_t*)(ws + WS_WXO); bf16_t* WOUT = (bf16_t*)(ws + WS_WOUT);
    bf16_t* WMKV = (bf16_t*)(ws + WS_WMKV); bf16_t* W2GU = (bf16_t*)(ws + WS_W2GU); bf16_t* W2D = (bf16_t*)(ws + WS_W2D);
    bf16_t* XN = (bf16_t*)(ws + WS_XN); bf16_t* ACT = (bf16_t*)(ws + WS_ACT); bf16_t* GT = (bf16_t*)(ws + WS_ACT); float* F = (float*)(ws + WS_F); float* H = (float*)(ws + WS_H);
    float* UP = (float*)(ws + WS_UP); float* US = (float*)(ws + WS_US); bf16_t* Q = (bf16_t*)(ws + WS_Q); bf16_t* DIFF = (bf16_t*)(ws + WS_DIFF); bf16_t* WPO2 = (bf16_t*)(ws + WS_Z); bf16_t* WPGS = (bf16_t*)(ws + WS_Z + 8 * MiB); bf16_t* WPGO = (bf16_t*)(ws + WS_Z + 12 * MiB);
    bf16_t* GS = (bf16_t*)(ws + WS_GS); bf16_t* XO = (bf16_t*)(ws + WS_XO); bf16_t* MB = (bf16_t*)(ws + WS_MB); bf16_t* MEMN = (bf16_t*)(ws + WS_MEMN);
    bf16_t* KB = (bf16_t*)(ws + WS_KB); bf16_t* VT = (bf16_t*)(ws + WS_VT); float* SLAB = (float*)(ws + WS_SLAB); float* SLAB7 = (float*)(ws + WS_SLAB7);
    const int lo = args.ph_lo, hi = args.ph_hi;
    LAS float* scr = (LAS float*)(lds + wave * 16640);
    constexpr int IT_GU = (DM / 64) * (DFF / 64), IT_D = IT_GU, IT_IN = (DM / 64) * (9216 / 64), IT_IN_P0 = 2816, IT_PG = 16, IT_1K2K = (1024 / 64) * (2048 / 64), IT_2K1K = IT_1K2K, IT_OUT = 32 * 32;
#define TAIL_BEGIN(units) { const int busy_ = (units) % G; if (bx >= busy_) { const int tw = (bx - busy_) * NWAVES + wave, ntw = (G - busy_) * NWAVES;
#define TAIL_END } }
#if MK_SINGLE
    for (int i = tid; i < LDS_BYTES / 16; i += NTHREADS) ((LAS u32x4*)lds)[i] = (u32x4){0u, 0u, 0u, 0u};
    __syncthreads();
    const XcdBarrier xbar = xcd_barrier_post((unsigned*)ws + CW_BAR, (volatile LAS unsigned*)(lds + MISC_OFF) + 8);
#define GRID_BAR() xcd_barrier(xbar)
#else
#define GRID_BAR() do { } while (0)
#endif
#define IN(k) (lo <= (k) && (k) < hi)
#define SEAM(k) do { if (IN(k) && IN((k) + 1)) GRID_BAR(); } while (0)

    if (IN(0)) {
        constexpr int NITEMS = 2 * IT_GU + IT_IN_P0 + 2 * IT_2K1K;
        for (int it = gw; it < NITEMS; it += ngw) {
            int r = it;
            if (cvt_mat(r, in[I_W1G], DM, DFF, W1GU, 1, 0, scr, lane)) continue;
            if (cvt_mat(r, in[I_W1U], DM, DFF, W1GU, 1, 128, scr, lane)) continue;
            if (cvt_mat(r, in[I_WMK], DM, 1024, WMKV, 0, 0, scr, lane)) continue;
            if (cvt_mat(r, in[I_WMV], DM, 1024, WMKV, 0, 1024, scr, lane)) continue;
            cvt_mat(r, in[I_WIN], DM, 9216, WIN, 0, 0, scr, lane);
        }
        for (int m = gw; m < MT; m += ngw) rms_row_bf16(xrow_ptr(in[I_XP], in[I_XS], m), in[I_G1PRE], XN + (size_t)m * DM, lane);
        for (int m = gw; m < MEMR; m += ngw) rms_row_bf16(in[I_MEM] + (size_t)m * DM, in[I_GMEM], MEMN + (size_t)m * DM, lane);
    }
    SEAM(0);
    if (IN(1)) {
        pg8::Sched2 S; S.A0 = (const char*)XN; S.B0 = (const char*)W1GU; S.nM0 = NMT; S.nN0 = 2 * DFF / 256; S.nt0 = DM / 64; S.ta0 = (size_t)256 * DM * 2; S.tb0 = (size_t)256 * DM * 2; S.ca0 = 0;
        S.A1 = (const char*)MEMN; S.B1 = (const char*)WMKV; S.nM1 = MEMR / 256; S.nN1 = 8; S.nt1 = DM / 64; S.ta1 = (size_t)256 * DM * 2; S.tb1 = (size_t)256 * DM * 2; S.ca1 = 0; S.G = G; S.c = bx;
        pg8::EpiUp E; E.ACT = ACT; E.outK = out + O_MK; E.outV = out + O_MV; E.KB = KB; E.VT = VT;
        pg8::gemm_phase(lds, DM, DM, S, E);
        TAIL_BEGIN(NMT * (2 * DFF / 256) + (MEMR / 256) * 8)
            for (int it = tw; it < IT_D + (IT_IN - IT_IN_P0); it += ntw) { int r = it;
                if (cvt_mat<64>(r, in[I_W1D], DFF, DM, W1D, 0, 0, scr, lane)) continue;
                r += IT_IN_P0; cvt_mat<64>(r, in[I_WIN], DM, 9216, WIN, 0, 0, scr, lane); }
        TAIL_END
    }
    SEAM(1);
    if (IN(2)) {
        pg8::SchedN2 S; S.A = (const char*)ACT; S.B = (const char*)W1D; S.nt = DFF / 64; S.ta = (size_t)256 * DFF * 2; S.tb = (size_t)256 * DFF * 2; S.G = G; S.c = bx;
        pg8::EpiF32 E; E.F = F; E.SLAB = SLAB;
        pg8::gemm_phase(lds, DFF, DFF, S, E);
        TAIL_BEGIN(256 + 8 * (DFF / 256))
            constexpr int NIT = 2 * IT_1K2K;
            for (int it = tw; it < NIT; it += ntw) {
                int r = it;
                if (cvt_mat<64>(r, in[I_WPO], 1024, DM, WPO2, 0, 0, scr, lane, DM)) continue;
                cvt_mat<64>(r, in[I_WXO], 1024, DM, WXO, 0, 0, scr, lane);
            }
            for (int q = tw * 64 + lane; q < 4 * 256 * 32; q += ntw * 64) {
                const int row = q >> 5, d0 = (q & 31) * 8; const float* wp = in[I_WPG] + (size_t)row * 256 + d0; const float* sp = in[I_PSCALE] + (row >> 8) * 256 + d0;
                *(u32x4*)(WPGS + (size_t)row * DM + d0) = pg8::pack8(*(const f32x4*)wp * *(const f32x4*)sp, *(const f32x4*)(wp + 4) * *(const f32x4*)(sp + 4));
            }
        TAIL_END
    }
    SEAM(2);
    if (IN(3)) { rowop_sample<0>(bx, G, wave, lane, lds, SLAB, DFF / 256, in[I_XS], H, in[I_G1POST], in[I_GMIXPRE], XN, nullptr);
        rowop<0>(gw, ngw, lane, F, SLAB, DFF / 256, in[I_XP], in[I_XS], H, in[I_G1POST], in[I_GMIXPRE], XN, nullptr); }
    SEAM(3);
    if (IN(4)) {
        pg8::Sched2 S; S.A0 = (const char*)XN; S.B0 = (const char*)WIN; S.nM0 = NMT; S.nN0 = 36; S.nt0 = DM / 64; S.ta0 = (size_t)256 * DM * 2; S.tb0 = (size_t)256 * DM * 2; S.ca0 = 0;
        S.A1 = (const char*)WPO2; S.B1 = (const char*)WPGS; S.nM1 = 8; S.nN1 = 4; S.nt1 = 4; S.ta1 = (size_t)256 * DM * 2; S.tb1 = (size_t)256 * DM * 2; S.ca1 = 512; S.G = G; S.c = bx;
        pg8::EpiIn E; E.UP = UP; E.US = US; E.Q = Q; E.G = GT; E.WPGO = WPGO;
        pg8::gemm_phase(lds, DM, DM, S, E);
        TAIL_BEGIN(NMT * 36)
            constexpr int NIT = 2 * IT_1K2K + IT_OUT + IT_GU;
            for (int it = tw; it < NIT; it += ntw) {
                int r = it;
                if (cvt_mat<64>(r, in[I_WGV], 1024, DM, WGLU, 1, 0, scr, lane)) continue;
                if (cvt_mat<64>(r, in[I_WGG], 1024, DM, WGLU, 1, 128, scr, lane)) continue;
                if (cvt_mat<64>(r, in[I_WOUT], DM, DM, WOUT, 0, 0, scr, lane)) continue;
                cvt_mat<64>(r, in[I_W2G], DM, DFF, W2GU, 1, 0, scr, lane);
            }
        TAIL_END
    }
    SEAM(4);
    if (IN(5)) {
        LAS unsigned* MISCW = (LAS unsigned*)(lds + MISC_OFF);
        if (wave < SSM_NW) {
            volatile LAS unsigned* flags = (volatile LAS unsigned*)MISCW + 16;
            unsigned epoch = 1;
            for (int un = bx; un < NBAT * 64; un += G, ++epoch) ssm_prompt_unit(un >> 6, un & 63, US, GS, out + O_SRP, out + O_SIP, in, lds, flags, epoch, wave, lane);
            for (int un = bx * SSM_NW + wave; un < 64 * 8; un += G * SSM_NW) ssm_sample_unit(un >> 3, un & 7, US, GS, in[I_SRE], in[I_SIM], out + O_SRS, out + O_SIS, in, lds, wave, lane);
        } else {
            const int pr = (wave - 4) >> 1, kh = (wave - 4) & 1;
            LAS float* xch = (LAS float*)(lds + 98304 + pr * 2048);
            unsigned epoch = 1;
            for (int un = bx * 2 + pr; un < MS * 4; un += G * 2, ++epoch)
                attn_sample_half(un >> 2, un & 3, kh, (un * 5) & 7, Q, in[I_CK], in[I_CV], XO, xch, (volatile LAS unsigned*)MISCW + 24 + pr, epoch, lane);
        }
        pool_steal(bx, G, MISCW + 26, lane, UP, in[I_SPOOL], DIFF, out + O_PP, out + O_PS);
        __syncthreads();
        for (int un = bx; un < NBAT * 4 * 16; un += G) attn_prompt_unit(un >> 6, (un >> 4) & 3, un & 15, Q, KB, VT, XO, lds, tid, wave, lane);
    }
    SEAM(5);
    if (IN(7)) {
        pg8::SchedBr S; S.Z = (const char*)DIFF; S.XO = (const char*)XO; S.GS = (const char*)GS; S.WPO = (const char*)WPGO; S.WXO = (const char*)WXO; S.WGLU = (const char*)WGLU; S.G = G; S.c = bx;
        pg8::EpiBr E; E.MG = F; E.MB = MB; E.G = GT; E.SLAB7 = SLAB7;
        pg8::gemm_phase(lds, 1024, 1024, S, E);
        TAIL_BEGIN(256 + 128)
            for (int it = tw; it < IT_GU / 2; it += ntw) { int r = it; cvt_mat<64>(r, in[I_W2U], DM, DFF, W2GU, 1, 128, scr, lane); }
        TAIL_END
    }
    SEAM(7);
    if (IN(8)) {
        for (int idx = gtid; idx < MS * 256; idx += ngt) {
            const int r = idx >> 8, c0 = (idx & 255) * 8, bt = c0 >> 7, wi = c0 & 127;
            f32x4 po[2] = {}, xa[2] = {}, va[2] = {}, ga[2] = {};
#pragma unroll
            for (int kc = 0; kc < 4; ++kc) { const float* sr = SLAB7 + ((size_t)kc * 128 + r) * 8192;
#pragma unroll
                for (int q = 0; q < 2; ++q) { po[q] += *(const f32x4*)(sr + c0 + 4 * q); xa[q] += *(const f32x4*)(sr + 2048 + c0 + 4 * q);
                    va[q] += *(const f32x4*)(sr + 4096 + bt * 256 + wi + 4 * q); ga[q] += *(const f32x4*)(sr + 4096 + bt * 256 + 128 + wi + 4 * q); } }
            const bf16_t* gr = GT + pg8::frag_off(32 * 24 + (c0 >> 8), 0, (r >> 4) & 3, (c0 >> 7) & 1, (r >> 6) & 1, (c0 >> 5) & 3, r & 15, (c0 >> 3) & 3);
            f32x4 g0a, g0b, g1a, g1b, g2a, g2b; pg8::unpack8(*(const u32x4*)gr, g0a, g0b); pg8::unpack8(*(const u32x4*)(gr + (size_t)8 * 65536), g1a, g1b); pg8::unpack8(*(const u32x4*)(gr + (size_t)16 * 65536), g2a, g2b);
            f32x4 o0, o1;
#pragma unroll
            for (int j = 0; j < 4; ++j) { o0[j] = g0a[j] * po[0][j] + g2a[j] * xa[0][j] + g1a[j] * va[0][j] * sigm(ga[0][j]); o1[j] = g0b[j] * po[1][j] + g2b[j] * xa[1][j] + g1b[j] * va[1][j] * sigm(ga[1][j]); }
            *(u32x4*)(MB + (size_t)(MP + r) * DM + c0) = pg8::pack8(o0, o1);
        }
    }
    SEAM(8);
    if (IN(9)) {
        pg8::SchedN2 S; S.A = (const char*)MB; S.B = (const char*)WOUT; S.nt = DM / 64; S.ta = (size_t)256 * DM * 2; S.tb = (size_t)256 * DM * 2; S.G = G; S.c = bx;
        pg8::EpiF32 E; E.F = F; E.SLAB = SLAB;
        pg8::gemm_phase(lds, DM, DM, S, E);
        TAIL_BEGIN(256 + 8 * (DM / 256))
            for (int it = IT_GU / 2 + tw; it < IT_GU; it += ntw) { int r = it; cvt_mat<64>(r, in[I_W2U], DM, DFF, W2GU, 1, 128, scr, lane); }
        TAIL_END
    }
    SEAM(9);
    if (IN(10)) { rowop_sample<1>(bx, G, wave, lane, lds, SLAB, DM / 256, nullptr, H, in[I_GMIXPOST], in[I_G2PRE], XN, nullptr);
        rowop<1>(gw, ngw, lane, F, SLAB, DM / 256, nullptr, nullptr, H, in[I_GMIXPOST], in[I_G2PRE], XN, nullptr); }
    SEAM(10);
    if (IN(11)) {
        pg8::Sched2 S; S.A0 = (const char*)XN; S.B0 = (const char*)W2GU; S.nM0 = NMT; S.nN0 = 2 * DFF / 256; S.nt0 = DM / 64; S.ta0 = (size_t)256 * DM * 2; S.tb0 = (size_t)256 * DM * 2; S.ca0 = 0;
        S.A1 = nullptr; S.B1 = nullptr; S.nM1 = 0; S.nN1 = 0; S.nt1 = 0; S.ta1 = 0; S.tb1 = 0; S.ca1 = 0; S.G = G; S.c = bx;
        pg8::EpiUp E; E.ACT = ACT; E.outK = nullptr; E.outV = nullptr; E.KB = nullptr; E.VT = nullptr;
        pg8::gemm_phase(lds, DM, DM, S, E);
        TAIL_BEGIN(NMT * (2 * DFF / 256))
            for (int it = tw; it < IT_D; it += ntw) { int r = it; cvt_mat<64>(r, in[I_W2D], DFF, DM, W2D, 0, 0, scr, lane); }
        TAIL_END
    }
    SEAM(11);
    if (IN(12)) {
        pg8::SchedN2 S; S.A = (const char*)ACT; S.B = (const char*)W2D; S.nt = DFF / 64; S.ta = (size_t)256 * DFF * 2; S.tb = (size_t)256 * DFF * 2; S.G = G; S.c = bx;
        pg8::EpiF32 E; E.F = F; E.SLAB = SLAB;
        pg8::gemm_phase(lds, DFF, DFF, S, E);
    }
    SEAM(12);
    if (IN(13)) { rowop_sample<2>(bx, G, wave, lane, lds, SLAB, DFF / 256, nullptr, H, in[I_G2POST], nullptr, nullptr, out + O_Y);
        rowop<2>(gw, ngw, lane, F, SLAB, DFF / 256, nullptr, nullptr, H, in[I_G2POST], nullptr, nullptr, out + O_Y); }
#undef IN
#undef SEAM
#undef GRID_BAR
#undef TAIL_BEGIN
#undef TAIL_END
}

extern "C" void kernel_launch(void* const* d_in, const int* in_sizes, int n_in, void* d_out, int out_size, void* d_ws, size_t ws_size, hipStream_t stream) {
    static int grid = 0;
    if (grid == 0) {
        if (n_in != N_IN || ws_size < WS_END) { fprintf(stderr, "kernel_launch: expected %d inputs and >= %zu bytes of workspace; got %d, %zu\n", (int)N_IN, (size_t)WS_END, n_in, ws_size); grid = -1; return; }
        int dev = 0, cus = 0, per_cu = 0;
        (void)hipGetDevice(&dev);
        (void)hipDeviceGetAttribute(&cus, hipDeviceAttributeMultiprocessorCount, dev);
        if (hipFuncSetAttribute((const void*)mk_fwd, hipFuncAttributeMaxDynamicSharedMemorySize, LDS_BYTES) != hipSuccess) { fprintf(stderr, "kernel_launch: hipFuncSetAttribute failed\n"); grid = -1; return; }
        if (hipOccupancyMaxActiveBlocksPerMultiprocessor(&per_cu, (const void*)mk_fwd, NTHREADS, LDS_BYTES) != hipSuccess || per_cu < 1) { fprintf(stderr, "kernel_launch: occupancy query says %d\n", per_cu); per_cu = 1; }
        (void)hipGetLastError();
        grid = cus;
        if (grid > cus * per_cu) grid = cus * per_cu;
    }
    if (grid < 0) return;
    Args a{};
    for (int i = 0; i < N_IN; ++i) a.in[i] = (const float*)d_in[i];
    a.out = (float*)d_out; a.ws = (unsigned char*)d_ws;
#if MK_SINGLE
    a.ph_lo = 0; a.ph_hi = NPHASE;
    if (hipMemsetAsync(d_ws, 0, CTL_ZERO_BYTES, stream) != hipSuccess) { fprintf(stderr, "kernel_launch: hipMemsetAsync failed\n"); return; }
    hipLaunchKernelGGL(mk_fwd, dim3(grid), dim3(NTHREADS), LDS_BYTES, stream, a);
#else
    for (int p = 0; p < NPHASE; ++p) {
        a.ph_lo = p; a.ph_hi = p + 1;
        hipLaunchKernelGGL(mk_fwd, dim3(grid), dim3(NTHREADS), LDS_BYTES, stream, a);
    }
#endif
}
```

```cpp
#include <hip/hip_runtime.h>
#include <cstdio>
#include <cstdint>

#ifndef MK_SINGLE
#define MK_SINGLE 1
#endif

#define LAS __attribute__((address_space(3)))
typedef unsigned short bf16_t;
typedef short bf16x8 __attribute__((ext_vector_type(8)));
typedef short s16x4 __attribute__((ext_vector_type(4)));
typedef float f32x4 __attribute__((ext_vector_type(4)));
typedef unsigned u32x4 __attribute__((ext_vector_type(4)));
typedef unsigned u32x2 __attribute__((ext_vector_type(2)));

constexpr int DM = 2048, SEQ = 2048, NBAT = 4, MP = NBAT * SEQ, MS = 128, MT = MP + MS, MPAD = 8448, NMT = MPAD / 256;
constexpr int DFF = 5632, NMEM = 256, MEMR = NBAT * NMEM;
constexpr int PW = 1024, GW = 6144;
constexpr float RMS_EPS = 1e-6f;
constexpr int NPHASE = 14;
constexpr int NTHREADS = 512, NWAVES = 8;
constexpr int LDS_BYTES = 147456;

constexpr size_t MiB = (size_t)1 << 20;
constexpr size_t WS_W1GU = 1 * MiB, WS_W1D = 45 * MiB, WS_WIN = 67 * MiB, WS_WPG = 103 * MiB, WS_WPO = 104 * MiB, WS_WGLU = 108 * MiB, WS_WXO = 116 * MiB,
                 WS_WOUT = 120 * MiB, WS_WMKV = 128 * MiB, WS_W2GU = 136 * MiB, WS_W2D = 180 * MiB;
constexpr size_t WS_XN = 202 * MiB, WS_ACT = 235 * MiB, WS_F = 334 * MiB, WS_H = 400 * MiB, WS_UP = 466 * MiB, WS_US = 499 * MiB, WS_Q = 532 * MiB,
                 WS_DIFF = 549 * MiB, WS_Z = 566 * MiB, WS_GS = 583 * MiB, WS_XO = 600 * MiB, WS_MB = 617 * MiB, WS_MEMN = 650 * MiB, WS_KB = 654 * MiB, WS_VT = 656 * MiB,
                 WS_SLAB = 658 * MiB, WS_SLAB7 = 680 * MiB, WS_END = 696 * MiB;
constexpr size_t O_Y = 0, O_MK = 17039360, O_MV = 18087936, O_PP = 19136512, O_SRP = 19197952, O_SIP = 19214336, O_PS = 19230720, O_SRS = 21196800, O_SIS = 21721088;

enum { I_XP = 0, I_XS, I_MEM, I_CK, I_CV, I_SPOOL, I_SRE, I_SIM, I_G1PRE, I_W1G, I_W1U, I_W1D, I_G1POST, I_GMIXPRE, I_WIN, I_WPG, I_PSCALE, I_WPO,
       I_ARE, I_AIM, I_LOGSTEP, I_BRE, I_BIM, I_CRE, I_CIM, I_SSMD, I_WGV, I_WGG, I_GMEM, I_WMK, I_WMV, I_WXO, I_WOUT, I_GMIXPOST, I_G2PRE, I_W2G, I_W2U, I_W2D, I_G2POST, N_IN };

struct Args { const float* in[N_IN]; float* out; unsigned char* ws; int ph_lo, ph_hi; };

#define LDS_WAIT() asm volatile("s_waitcnt lgkmcnt(0)" ::: "memory")
__device__ __forceinline__ unsigned cvt_pk_bf16(float lo, float hi) { unsigned r; asm volatile("v_cvt_pk_bf16_f32 %0, %1, %2" : "=v"(r) : "v"(lo), "v"(hi)); return r; }
__device__ __forceinline__ float bf2f(unsigned short b) { return __uint_as_float(((unsigned)b) << 16); }
__device__ __forceinline__ float wave_sum(float v) {
#pragma unroll
    for (int o = 1; o < 64; o <<= 1) v += __shfl_xor(v, o);
    return v;
}
__device__ __forceinline__ float wave_max(float v) {
#pragma unroll
    for (int o = 1; o < 64; o <<= 1) v = fmaxf(v, __shfl_xor(v, o));
    return v;
}
__device__ __forceinline__ float sigm(float x) { return __builtin_amdgcn_rcpf(1.0f + __expf(-x)); }
__device__ __forceinline__ float gelu_tanh(float x) {
    const float z = 0.7978845608028654f * (x + 0.044715f * x * x * x);
    const float e = __expf(2.0f * z);
    const float th = 1.0f - 2.0f * __builtin_amdgcn_rcpf(e + 1.0f);
    return 0.5f * x * (1.0f + th);
}

__device__ __forceinline__ size_t us_off(size_t row, int c) {
    const int g = c >> 4, w = c & 15;
    return row < (size_t)MP ? ((((row >> 11) * 64 + g) * 2048 + (row & 2047)) * 16 + w) : ((size_t)NBAT * 64 * 2048 * 16 + ((size_t)g * 256 + (row - MP)) * 16 + w);
}
namespace pg8 {
constexpr int BM = 256, BK = 64, HALF = 128, HTB = HALF * BK * 2, STAGE_BYTES = 8 * HTB;
__device__ __forceinline__ int lds_byte(int r, int c) { const int st = (r >> 4) * 2 + (c >> 5), rr = r & 15, cc = c & 31, ob = rr * 64 + cc * 2; return st * 1024 + (ob ^ (((ob >> 9) & 1) << 5)); }
__device__ __forceinline__ void stage_rc(int b, int& R, int& C) { const int st = b / 1024, sb = b % 1024, swz = sb ^ (((sb >> 9) & 1) << 5); R = (st >> 1) * 16 + swz / 64; C = (st & 1) * 32 + (swz % 64) / 2; }
__device__ __forceinline__ int perm32(int rho) { const int n = rho >> 4, i = rho & 15; return 8 * (i >> 2) + 4 * n + (i & 3); }

struct Unit { const char* A; const char* B; int nt, pm, pn, kind, aux; };

__device__ __forceinline__ void tile_of(int L, int nM, int nN, int& pm, int& pn) {
    const int nwg = nM * nN; int wgid = L;
    { const int q = nwg / 8, r = nwg % 8, xcd = wgid % 8, off = wgid / 8; wgid = (xcd < r ? xcd * (q + 1) : r * (q + 1) + (xcd - r) * q) + off; }
    const int nig = 8 * nN, gid = wgid / nig, fm = gid * 8, gsz = (nM - fm) < 8 ? (nM - fm) : 8;
    pm = fm + ((wgid % nig) % gsz); pn = (wgid % nig) / gsz;
}

template <class Epi, class Sched>
__device__ __forceinline__ void gemm_phase(LAS unsigned char* lds, const int lda, const int ldb, const Sched& S, const Epi& E) {
    const int tid = threadIdx.x, wid = __builtin_amdgcn_readfirstlane(tid >> 6), lane = tid & 63, wr = wid >> 2, wc = wid & 3, fr = lane & 15, fq = lane >> 4;
    unsigned voffA[2], voffB[2];
#pragma unroll
    for (int i = 0; i < 2; ++i) { int R, C; stage_rc(tid * 16 + i * 8192, R, C); const int Rb = (R & ~31) + perm32(R & 31);
        voffA[i] = (unsigned)(R * lda + C) * 2u; voffB[i] = (unsigned)(Rb * ldb + C) * 2u; }
    const size_t kstep = (size_t)(BK * 2);
    const size_t hstepA = (size_t)HALF * lda * 2, hstepB = (size_t)HALF * ldb * 2;
    const unsigned ldsw = (unsigned)wid * 1024u;
    const int aoff = lds_byte(wr * 64 + fr, fq * 8), boff = lds_byte(wc * 32 + fr, fq * 8);
#define PG8_SA(b, h) (((b) * 2 + (h)) * HTB)
#define PG8_SB(b, h) ((4 + (b) * 2 + (h)) * HTB)
#define PG8_STAGE(bufoff, gbase, voff) do { _Pragma("unroll") for (int _i = 0; _i < 2; ++_i) \
        __builtin_amdgcn_global_load_lds((const unsigned*)((const char*)(gbase) + (voff)[_i]), (LAS unsigned*)(lds + (bufoff) + ldsw + _i * 8192), 16, 0, 0); } while (0)
#define PG8_LDA(dst, b, h) do { _Pragma("unroll") for (int m = 0; m < 4; ++m) _Pragma("unroll") for (int k = 0; k < 2; ++k) dst[m][k] = *(const LAS bf16x8*)(lds + PG8_SA(b, h) + aoff + m * 2048 + k * 1024); } while (0)
#define PG8_LDB(dst, b, h) do { _Pragma("unroll") for (int n = 0; n < 2; ++n) _Pragma("unroll") for (int k = 0; k < 2; ++k) dst[n][k] = *(const LAS bf16x8*)(lds + PG8_SB(b, h) + boff + n * 2048 + k * 1024); } while (0)
#define PG8_MMA(ai, bj, At, Bt) do { __builtin_amdgcn_s_setprio(1); _Pragma("unroll") for (int m = 0; m < 4; ++m) _Pragma("unroll") for (int n = 0; n < 2; ++n) _Pragma("unroll") for (int k = 0; k < 2; ++k) \
        acc[ai][bj][m][n] = __builtin_amdgcn_mfma_f32_16x16x32_bf16(Bt[n][k], At[m][k], acc[ai][bj][m][n], 0, 0, 0); __builtin_amdgcn_s_setprio(0); } while (0)
#define PG8_WAIT_V(n) asm volatile("s_waitcnt vmcnt(" #n ")" ::: "memory")
#define PG8_WAIT_L(n) asm volatile("s_waitcnt lgkmcnt(" #n ")" ::: "memory")
#define PG8_BAR __builtin_amdgcn_s_barrier()
#define PG8_SCHED __builtin_amdgcn_sched_barrier(0)
    Unit cur, nxt; int ui = 0;
    if (!S.next(0, cur)) return;
    f32x4 acc[2][2][4][2];
#pragma unroll
    for (int a = 0; a < 2; ++a)
#pragma unroll
        for (int b = 0; b < 2; ++b)
#pragma unroll
            for (int m = 0; m < 4; ++m)
#pragma unroll
                for (int n = 0; n < 2; ++n) acc[a][b][m][n] = (f32x4){0.f, 0.f, 0.f, 0.f};
    bf16x8 At[4][2], B0[2][2], B1[2][2];
    const char* cA = cur.A; const char* cB = cur.B;
    PG8_STAGE(PG8_SB(0, 0), cB, voffB); PG8_STAGE(PG8_SB(0, 1), cB + hstepB, voffB); PG8_STAGE(PG8_SA(0, 0), cA, voffA); PG8_STAGE(PG8_SA(0, 1), cA + hstepA, voffA);
    if (wr == 1) PG8_BAR;
    PG8_WAIT_V(2); PG8_BAR;
    PG8_STAGE(PG8_SB(1, 0), cB + kstep, voffB); PG8_STAGE(PG8_SA(1, 0), cA + kstep, voffA); PG8_STAGE(PG8_SB(1, 1), cB + hstepB + kstep, voffB);
    PG8_WAIT_V(6); PG8_BAR;
    for (;;) {
        const bool has_next = S.next(ui + 1, nxt);
        const char* nA = has_next ? nxt.A : cA; const char* nB = has_next ? nxt.B : cB;
        const int nt = cur.nt;
        for (int t = 0; t < nt; t += 2) {
            const bool last = (t == nt - 2);
            const char* a1 = cA + (size_t)(t + 1) * kstep;
            const char* a2 = last ? nA : cA + (size_t)(t + 2) * kstep; const char* b2 = last ? nB : cB + (size_t)(t + 2) * kstep;
            const char* a3 = a2 + kstep; const char* b3 = b2 + kstep;
            PG8_LDB(B0, 0, 0); PG8_LDB(B1, 0, 1); PG8_SCHED; PG8_LDA(At, 0, 0); PG8_STAGE(PG8_SA(1, 1), a1 + hstepA, voffA);
            PG8_WAIT_V(8); PG8_WAIT_L(0); PG8_BAR; PG8_MMA(0, 0, At, B0); PG8_MMA(0, 1, At, B1); PG8_BAR; PG8_SCHED;
            PG8_LDA(At, 0, 1); PG8_STAGE(PG8_SB(0, 0), b2, voffB); PG8_STAGE(PG8_SB(0, 1), b2 + hstepB, voffB); PG8_STAGE(PG8_SA(0, 0), a2, voffA);
            PG8_WAIT_V(8); PG8_WAIT_L(0); PG8_BAR; PG8_MMA(1, 0, At, B0); PG8_MMA(1, 1, At, B1); PG8_BAR; PG8_SCHED;
            PG8_LDB(B0, 1, 0); PG8_LDB(B1, 1, 1); PG8_SCHED; PG8_LDA(At, 1, 0); PG8_STAGE(PG8_SA(0, 1), a2 + hstepA, voffA);
            PG8_WAIT_V(8); PG8_WAIT_L(0); PG8_BAR; PG8_MMA(0, 0, At, B0); PG8_MMA(0, 1, At, B1); PG8_BAR; PG8_SCHED;
            PG8_LDA(At, 1, 1); PG8_STAGE(PG8_SB(1, 0), b3, voffB); PG8_STAGE(PG8_SB(1, 1), b3 + hstepB, voffB); PG8_STAGE(PG8_SA(1, 0), a3, voffA);
            PG8_WAIT_V(8); PG8_WAIT_L(0); PG8_BAR; PG8_MMA(1, 0, At, B0); PG8_MMA(1, 1, At, B1); PG8_BAR; PG8_SCHED;
        }
        if (wr == 0) PG8_BAR;
        E(acc, cur, wr, wc, fr, fq);
        if (!has_next) break;
#pragma unroll
        for (int a = 0; a < 2; ++a)
#pragma unroll
            for (int b = 0; b < 2; ++b)
#pragma unroll
                for (int m = 0; m < 4; ++m)
#pragma unroll
                    for (int n = 0; n < 2; ++n) acc[a][b][m][n] = (f32x4){0.f, 0.f, 0.f, 0.f};
        cur = nxt; cA = nA; cB = nB; ++ui;
        if (wr == 1) PG8_BAR;
    }
    PG8_WAIT_V(0);
    PG8_BAR;
#undef PG8_SA
#undef PG8_SB
#undef PG8_STAGE
#undef PG8_LDA
#undef PG8_LDB
#undef PG8_MMA
#undef PG8_WAIT_V
#undef PG8_WAIT_L
#undef PG8_BAR
#undef PG8_SCHED
}

struct Sched2 {
    const char *A0, *B0; int nM0, nN0, nt0; size_t ta0, tb0, ca0;
    const char *A1, *B1; int nM1, nN1, nt1; size_t ta1, tb1, ca1;
    int G, c;
    __device__ __forceinline__ bool next(int i, Unit& u) const {
        int L = i * G + c; const int n0 = nM0 * nN0, n1 = nM1 * nN1;
        if (L < n0) { int pm, pn; tile_of(L, nM0, nN0, pm, pn); u.A = A0 + (size_t)pm * ta0 + (size_t)pn * ca0; u.B = B0 + (size_t)pn * tb0; u.nt = nt0; u.pm = pm; u.pn = pn; u.kind = 0; u.aux = 0; return true; }
        L -= n0;
        if (L < n1) { int pm, pn; tile_of(L, nM1, nN1, pm, pn); u.A = A1 + (size_t)pm * ta1 + (size_t)pn * ca1; u.B = B1 + (size_t)pn * tb1; u.nt = nt1; u.pm = pm; u.pn = pn; u.kind = 1; u.aux = 0; return true; }
        return false;
    }
};
struct SchedN2 {
    const char *A, *B; int nt; size_t ta, tb; int G, c; bool minis;
    __device__ __forceinline__ bool next(int i, Unit& u) const {
        const int np = c < 256 ? (256 - c + G - 1) / G : 0;
        if (i < np) { int pm, pn; tile_of(i * G + c, 32, 8, pm, pn); u.A = A + (size_t)pm * ta; u.B = B + (size_t)pn * tb; u.nt = nt; u.pm = pm; u.pn = pn; u.kind = 0; u.aux = 0; return true; }
        if (!minis) return false;
        const int j = (i - np) * G + c;
        if (j >= 8 * (nt >> 2)) return false;
        const int pn = j & 7, kc = j >> 3;
        u.A = A + (size_t)32 * ta + (size_t)kc * 512; u.B = B + (size_t)pn * tb + (size_t)kc * 512; u.nt = 4; u.pm = 32; u.pn = pn; u.kind = 1; u.aux = kc; return true;
    }
};
struct SchedMini {
    const char *A, *B; int nt; size_t ta, tb; int c;
    __device__ __forceinline__ bool next(int i, Unit& u) const {
        if (i != 0 || c >= 8 * (nt >> 2)) return false;
        const int pn = c & 7, kc = c >> 3;
        u.A = A + (size_t)32 * ta + (size_t)kc * 512; u.B = B + (size_t)pn * tb + (size_t)kc * 512; u.nt = 4; u.pm = 32; u.pn = pn; u.kind = 1; u.aux = kc; return true;
    }
};
struct SchedBr {
    const char *Z, *XO, *GS, *WPO, *WXO, *WGLU; int G, c;
    __device__ __forceinline__ bool next(int i, Unit& u) const {
        const int ns = c < 256 ? (256 - c + G - 1) / G : 0;
        const size_t brow = (size_t)256 * 1024 * 2;
        const bool mini_first = (G == 256) && (c < 128);
        if (mini_first) { if (i == 0) i = 4 * ns; else if (i > 4 * ns) return false; else i -= 1; }
        if (i < 4 * ns) {
            const int s = i >> 2, sub = i & 3; int pm, pn; tile_of(s * G + c, 32, 8, pm, pn);
            const size_t arow = (size_t)pm * 256 * 1024 * 2;
            if (sub == 0) { u.A = Z + arow; u.B = WPO + (size_t)pn * brow; }
            else if (sub == 1) { u.A = XO + arow; u.B = WXO + (size_t)pn * brow; }
            else { u.A = GS + arow; u.B = WGLU + (size_t)(2 * pn + (sub - 2)) * brow; }
            u.nt = 16; u.pm = pm; u.pn = pn; u.kind = sub; u.aux = 0; return true;
        }
        const int j = (i - 4 * ns) * G + c;
        if (j >= 128) return false;
        const int tt = j & 31, kc = j >> 5; const size_t arow = (size_t)32 * 256 * 1024 * 2 + (size_t)kc * 512;
        if (tt < 8) { u.A = Z + arow; u.B = WPO + (size_t)tt * brow + (size_t)kc * 512; }
        else if (tt < 16) { u.A = XO + arow; u.B = WXO + (size_t)(tt - 8) * brow + (size_t)kc * 512; }
        else { u.A = GS + arow; u.B = WGLU + (size_t)(tt - 16) * brow + (size_t)kc * 512; }
        u.nt = 4; u.pm = 32; u.pn = tt; u.kind = 4; u.aux = kc; return true;
    }
};

#define EPI_ARGS const f32x4 (&acc)[2][2][4][2], const Unit& u, int wr, int wc, int fr, int fq
__device__ __forceinline__ u32x4 pack8(const f32x4& a, const f32x4& b) { u32x4 w; w.x = cvt_pk_bf16(a[0], a[1]); w.y = cvt_pk_bf16(a[2], a[3]); w.z = cvt_pk_bf16(b[0], b[1]); w.w = cvt_pk_bf16(b[2], b[3]); return w; }

__device__ __forceinline__ size_t frag_off(int tile, int ai, int m, int bj, int wr, int wc, int fr, int fq) {
    return ((size_t)tile * 16 + (size_t)((ai * 4 + m) * 2 + bj)) * 4096 + (size_t)(((wr * 4 + wc) * 64 + fq * 16 + fr) * 8);
}
struct EpiUp {
    bf16_t* ACT; float* outK; float* outV; bf16_t* KB; bf16_t* VT;
    __device__ __forceinline__ void operator()(EPI_ARGS) const {
        if (u.kind == 0) {
            const int row0 = u.pm * 256 + wr * 64 + fr, a0 = u.pn * 128 + wc * 32 + 8 * fq;
#pragma unroll
            for (int ai = 0; ai < 2; ++ai)
#pragma unroll
                for (int m = 0; m < 4; ++m) {
                    f32x4 v0, v1;
#pragma unroll
                    for (int j = 0; j < 4; ++j) { const float g0 = acc[ai][0][m][0][j], g1 = acc[ai][0][m][1][j];
                        v0[j] = g0 * sigm(g0) * acc[ai][1][m][0][j]; v1[j] = g1 * sigm(g1) * acc[ai][1][m][1][j]; }
                    *(u32x4*)(ACT + (size_t)(row0 + ai * 128 + m * 16) * DFF + a0) = pack8(v0, v1);
                }
        } else {
            const int row0 = u.pm * 256 + wr * 64 + fr;
#pragma unroll
            for (int ai = 0; ai < 2; ++ai)
#pragma unroll
                for (int m = 0; m < 4; ++m) {
                    const int r = row0 + ai * 128 + m * 16;
#pragma unroll
                    for (int bj = 0; bj < 2; ++bj) {
                        const int c0 = u.pn * 256 + bj * 128 + wc * 32 + 8 * fq;
                        const f32x4 v0 = acc[ai][bj][m][0], v1 = acc[ai][bj][m][1];
                        if (u.pn < 4) {
                            float* o = outK + (size_t)r * 1024 + c0; *(f32x4*)o = v0; *(f32x4*)(o + 4) = v1;
                            *(u32x4*)(KB + (size_t)r * 1024 + c0) = pack8(v0, v1);
                        } else {
                            const int cc = c0 - 1024;
                            float* o = outV + (size_t)r * 1024 + cc; *(f32x4*)o = v0; *(f32x4*)(o + 4) = v1;
                            const u32x4 w = pack8(v0, v1);
                            bf16_t* vt = VT + ((size_t)((r >> 8) * 4 + (cc >> 8)) * 256 + (cc & 255)) * 256 + (r & 255);
                            vt[0 * 256] = (bf16_t)(w.x & 0xffff); vt[1 * 256] = (bf16_t)(w.x >> 16); vt[2 * 256] = (bf16_t)(w.y & 0xffff); vt[3 * 256] = (bf16_t)(w.y >> 16);
                            vt[4 * 256] = (bf16_t)(w.z & 0xffff); vt[5 * 256] = (bf16_t)(w.z >> 16); vt[6 * 256] = (bf16_t)(w.w & 0xffff); vt[7 * 256] = (bf16_t)(w.w >> 16);
                        }
                    }
                }
        }
    }
};
struct EpiF32 {
    float* F; float* SLAB;
    __device__ __forceinline__ void operator()(EPI_ARGS) const {
        if (u.kind == 0) {
            const int row0 = u.pm * 256 + wr * 64 + fr;
#pragma unroll
            for (int ai = 0; ai < 2; ++ai)
#pragma unroll
                for (int m = 0; m < 4; ++m) {
                    bf16_t* rp = (bf16_t*)F + (size_t)(row0 + ai * 128 + m * 16) * DM + u.pn * 256 + wc * 32 + 8 * fq;
#pragma unroll
                    for (int bj = 0; bj < 2; ++bj) *(u32x4*)(rp + bj * 128) = pack8(acc[ai][bj][m][0], acc[ai][bj][m][1]);
                }
        } else {
#pragma unroll
            for (int m = 0; m < 4; ++m) {
                float* rp = SLAB + ((size_t)u.aux * 128 + wr * 64 + m * 16 + fr) * DM + u.pn * 256 + wc * 32 + 8 * fq;
#pragma unroll
                for (int bj = 0; bj < 2; ++bj) { *(f32x4*)(rp + bj * 128) = acc[0][bj][m][0]; *(f32x4*)(rp + bj * 128 + 4) = acc[0][bj][m][1]; }
            }
        }
    }
};
struct EpiIn {
    float* UP; float* US; bf16_t* Q; bf16_t* G; bf16_t* WPGO;
    __device__ __forceinline__ void operator()(EPI_ARGS) const {
        const int row0 = u.pm * 256 + wr * 64 + fr, pn = u.pn;
        if (u.kind == 1) {
#pragma unroll
            for (int ai = 0; ai < 2; ++ai)
#pragma unroll
                for (int m = 0; m < 4; ++m)
#pragma unroll
                    for (int bj = 0; bj < 2; ++bj)
                        *(u32x4*)(WPGO + (size_t)(row0 + ai * 128 + m * 16) * 1024 + pn * 256 + bj * 128 + wc * 32 + 8 * fq) = pack8(acc[ai][bj][m][0], acc[ai][bj][m][1]);
            return;
        }
#pragma unroll
        for (int ai = 0; ai < 2; ++ai)
#pragma unroll
            for (int m = 0; m < 4; ++m) {
                const size_t r = (size_t)(row0 + ai * 128 + m * 16);
#pragma unroll
                for (int bj = 0; bj < 2; ++bj) {
                    const int c0 = pn * 256 + bj * 128 + wc * 32 + 8 * fq;
                    f32x4 v0 = acc[ai][bj][m][0], v1 = acc[ai][bj][m][1];
                    if (pn < 4) *(u32x4*)((bf16_t*)UP + r * 1024 + c0) = pack8(v0, v1);
                    else if (pn < 8) *(u32x4*)((bf16_t*)US + us_off(r, c0 - 1024)) = pack8(v0, v1);
                    else if (pn < 12) { v0 *= 0.0625f; v1 *= 0.0625f; *(u32x4*)(Q + r * 1024 + (c0 - 2048)) = pack8(v0, v1); }
                    else {
#pragma unroll
                        for (int j = 0; j < 4; ++j) { v0[j] = sigm(v0[j]); v1[j] = sigm(v1[j]); }
                        *(u32x4*)(G + frag_off(u.pm * 24 + (pn - 12), ai, m, bj, wr, wc, fr, fq)) = pack8(v0, v1);
                    }
                }
            }
    }
};
__device__ __forceinline__ void unpack8(const u32x4& w, f32x4& a, f32x4& b) {
    a[0] = __uint_as_float(w.x << 16); a[1] = __uint_as_float(w.x & 0xffff0000u); a[2] = __uint_as_float(w.y << 16); a[3] = __uint_as_float(w.y & 0xffff0000u);
    b[0] = __uint_as_float(w.z << 16); b[1] = __uint_as_float(w.z & 0xffff0000u); b[2] = __uint_as_float(w.w << 16); b[3] = __uint_as_float(w.w & 0xffff0000u);
}
struct EpiBr {
    float* MG; bf16_t* MB; const bf16_t* G; float* SLAB7;
    __device__ __forceinline__ void operator()(EPI_ARGS) const {
        const int row0 = u.pm * 256 + wr * 64 + fr, kind = u.kind;
        if (kind == 4) {
#pragma unroll
            for (int m = 0; m < 4; ++m) {
                float* rp = SLAB7 + ((size_t)u.aux * 128 + wr * 64 + m * 16 + fr) * 8192 + u.pn * 256 + wc * 32 + 8 * fq;
#pragma unroll
                for (int bj = 0; bj < 2; ++bj) { *(f32x4*)(rp + bj * 128) = acc[0][bj][m][0]; *(f32x4*)(rp + bj * 128 + 4) = acc[0][bj][m][1]; }
            }
            return;
        }
        if (kind >= 2) {
            u32x4 gq[2][4], oq[2][4];
#pragma unroll
            for (int ai = 0; ai < 2; ++ai)
#pragma unroll
                for (int m = 0; m < 4; ++m) { gq[ai][m] = *(const u32x4*)(G + frag_off(u.pm * 24 + 8 + u.pn, ai, m, kind - 2, wr, wc, fr, fq)); oq[ai][m] = *(const u32x4*)((const bf16_t*)MG + frag_off(u.pm * 8 + u.pn, ai, m, kind - 2, wr, wc, fr, fq)); }
            __builtin_amdgcn_sched_barrier(0);
#pragma unroll
            for (int ai = 0; ai < 2; ++ai)
#pragma unroll
                for (int m = 0; m < 4; ++m) { const size_t r = (size_t)(row0 + ai * 128 + m * 16); const int c0 = u.pn * 256 + (kind - 2) * 128 + wc * 32 + 8 * fq;
                    f32x4 g0, g1; unpack8(gq[ai][m], g0, g1);
                    f32x4 v0, v1; unpack8(oq[ai][m], v0, v1);
#pragma unroll
                    for (int j = 0; j < 4; ++j) { v0[j] += g0[j] * acc[ai][0][m][0][j] * sigm(acc[ai][1][m][0][j]); v1[j] += g1[j] * acc[ai][0][m][1][j] * sigm(acc[ai][1][m][1][j]); }
                    *(u32x4*)(MB + r * DM + c0) = pack8(v0, v1); }
            return;
        }
#pragma unroll
        for (int ai = 0; ai < 2; ++ai) {
            u32x4 gq[4][2], pq[4][2];
#pragma unroll
            for (int m = 0; m < 4; ++m)
#pragma unroll
                for (int bj = 0; bj < 2; ++bj) {
                    gq[m][bj] = *(const u32x4*)(G + frag_off(u.pm * 24 + (kind == 0 ? 0 : 16) + u.pn, ai, m, bj, wr, wc, fr, fq));
                    if (kind == 1) pq[m][bj] = *(const u32x4*)((const bf16_t*)MG + frag_off(u.pm * 8 + u.pn, ai, m, bj, wr, wc, fr, fq)); }
            __builtin_amdgcn_sched_barrier(0);
#pragma unroll
            for (int m = 0; m < 4; ++m)
#pragma unroll
                for (int bj = 0; bj < 2; ++bj) {
                    f32x4 g0, g1; unpack8(gq[m][bj], g0, g1);
                    f32x4 v0 = g0 * acc[ai][bj][m][0], v1 = g1 * acc[ai][bj][m][1];
                    if (kind == 1) { f32x4 p0, p1; unpack8(pq[m][bj], p0, p1); v0 += p0; v1 += p1; }
                    *(u32x4*)((bf16_t*)MG + frag_off(u.pm * 8 + u.pn, ai, m, bj, wr, wc, fr, fq)) = pack8(v0, v1); }
        }
    }
};
}

template <int DEPTH>
__device__ __forceinline__ void cvt_item(const float* __restrict__ W, int N, bf16_t* D, int ldk, int k0, int n0, int drow0, LAS float* scr, int lane) {
    const float* src = W + (size_t)k0 * N + n0 + lane;
#pragma unroll
    for (int i0 = 0; i0 < 64; i0 += DEPTH) {
        float v[DEPTH];
#pragma unroll
        for (int d = 0; d < DEPTH; ++d) v[d] = __builtin_nontemporal_load(src + (size_t)(i0 + d) * N);
        __builtin_amdgcn_sched_barrier(0);
#pragma unroll
        for (int d = 0; d < DEPTH; ++d) scr[(i0 + d) * 65 + lane] = v[d];
    }
    LDS_WAIT();
    const int c = lane & 7;
#pragma unroll
    for (int j = 0; j < 8; ++j) { const int n = (lane >> 3) + 8 * j; const LAS float* s = scr + (8 * c) * 65 + n;
        u32x4 o; o.x = cvt_pk_bf16(s[0 * 65], s[1 * 65]); o.y = cvt_pk_bf16(s[2 * 65], s[3 * 65]); o.z = cvt_pk_bf16(s[4 * 65], s[5 * 65]); o.w = cvt_pk_bf16(s[6 * 65], s[7 * 65]);
        *(u32x4*)(D + (size_t)(drow0 + n) * ldk + k0 + 8 * c) = o; }
    LDS_WAIT();
}
template <int DEPTH = 16>
__device__ __forceinline__ bool cvt_mat(int& r, const float* W, int K, int N, bf16_t* D, int mode, int roff, LAS float* scr, int lane, int ldk = 0) {
    const int nb = N / 64, items = (K / 64) * nb;
    if (r >= items) { r -= items; return false; }
    const int nkb = K / 64; const int kb = r % nkb, n0 = (r / nkb) * 64;
    const int drow0 = mode ? ((n0 >> 7) * 256 + roff + (n0 & 127)) : (roff + n0);
    cvt_item<DEPTH>(W, N, D, ldk ? ldk : K, kb * 64, n0, drow0, scr, lane);
    return true;
}
__device__ __forceinline__ void rms_row_bf16(const float* xrow, const float* g, bf16_t* orow, int lane) {
    f32x4 v[8]; float s = 0.f;
#pragma unroll
    for (int j = 0; j < 8; ++j) { v[j] = *(const f32x4*)(xrow + 4 * lane + 256 * j); s += (v[j][0] * v[j][0] + v[j][1] * v[j][1]) + (v[j][2] * v[j][2] + v[j][3] * v[j][3]); }
    const float r = 1.0f / sqrtf(wave_sum(s) * (1.0f / DM) + RMS_EPS);
#pragma unroll
    for (int j = 0; j < 8; ++j) { const f32x4 gv = *(const f32x4*)(g + 4 * lane + 256 * j); const f32x4 o = v[j] * r * gv;
        u32x2 w; w.x = cvt_pk_bf16(o[0], o[1]); w.y = cvt_pk_bf16(o[2], o[3]); *(u32x2*)(orow + 4 * lane + 256 * j) = w; }
}
__device__ __forceinline__ const float* xrow_ptr(const float* xp, const float* xs, int m) { return m < MP ? xp + (size_t)m * DM : xs + (size_t)(m - MP) * DM; }

template <int MODE>
__device__ __forceinline__ void rowop(int gw, int ngw, int lane, const float* F, const float* SLAB, int nslab, const float* xp, const float* xs, float* H, const float* gpost, const float* gpre, bf16_t* XN, float* out) {
    for (int m = gw; m < MP; m += ngw) {
        const bf16_t* frow = (const bf16_t*)F + (size_t)m * DM; const float* brow = (MODE == 0) ? xrow_ptr(xp, xs, m) : nullptr; const bf16_t* hrow = (const bf16_t*)H + (size_t)m * DM;
        f32x4 f[8]; float s = 0.f;
        if (m < MP) {
#pragma unroll
            for (int j = 0; j < 8; ++j) { const u32x2 w = __builtin_nontemporal_load((const u32x2*)(frow + 4 * lane + 256 * j));
                f[j][0] = __uint_as_float(w.x << 16); f[j][1] = __uint_as_float(w.x & 0xffff0000u); f[j][2] = __uint_as_float(w.y << 16); f[j][3] = __uint_as_float(w.y & 0xffff0000u); }
        } else {
#pragma unroll
            for (int j = 0; j < 8; ++j) f[j] = (f32x4){0.f, 0.f, 0.f, 0.f};
            for (int k = 0; k < nslab; ++k) { const float* srow = SLAB + ((size_t)k * 128 + (m - MP)) * DM;
#pragma unroll
                for (int j = 0; j < 8; ++j) f[j] += *(const f32x4*)(srow + 4 * lane + 256 * j); }
        }
#pragma unroll
        for (int j = 0; j < 8; ++j) s += (f[j][0] * f[j][0] + f[j][1] * f[j][1]) + (f[j][2] * f[j][2] + f[j][3] * f[j][3]);
        const float r = ((MODE == 1) ? 1.0f : 0.5f) / sqrtf(wave_sum(s) * (1.0f / DM) + RMS_EPS);
        float s2 = 0.f;
#pragma unroll
        for (int j = 0; j < 8; ++j) { const f32x4 gv = *(const f32x4*)(gpost + 4 * lane + 256 * j); f32x4 bv; if (MODE == 0) bv = __builtin_nontemporal_load((const f32x4*)(brow + 4 * lane + 256 * j)); else { const u32x2 hw = __builtin_nontemporal_load((const u32x2*)(hrow + 4 * lane + 256 * j)); bv[0] = __uint_as_float(hw.x << 16); bv[1] = __uint_as_float(hw.x & 0xffff0000u); bv[2] = __uint_as_float(hw.y << 16); bv[3] = __uint_as_float(hw.y & 0xffff0000u); }
            f[j] = bv + f[j] * r * gv; s2 += (f[j][0] * f[j][0] + f[j][1] * f[j][1]) + (f[j][2] * f[j][2] + f[j][3] * f[j][3]); }
        if (MODE == 2) {
#pragma unroll
            for (int j = 0; j < 8; ++j) __builtin_nontemporal_store(f[j], (f32x4*)(out + (size_t)m * DM + 4 * lane + 256 * j));
        } else {
            const float r2 = 1.0f / sqrtf(wave_sum(s2) * (1.0f / DM) + RMS_EPS);
#pragma unroll
            for (int j = 0; j < 8; ++j) { { u32x2 hw; hw.x = cvt_pk_bf16(f[j][0], f[j][1]); hw.y = cvt_pk_bf16(f[j][2], f[j][3]); __builtin_nontemporal_store(hw, (u32x2*)((bf16_t*)H + (size_t)m * DM + 4 * lane + 256 * j)); }
                const f32x4 gv = *(const f32x4*)(gpre + 4 * lane + 256 * j); const f32x4 o = f[j] * r2 * gv;
                u32x2 w; w.x = cvt_pk_bf16(o[0], o[1]); w.y = cvt_pk_bf16(o[2], o[3]); *(u32x2*)(XN + (size_t)m * DM + 4 * lane + 256 * j) = w; }
        }
    }
}

__device__ __forceinline__ f32x4 bf4(const u32x2& w) { f32x4 r; r[0] = __uint_as_float(w.x << 16); r[1] = __uint_as_float(w.x & 0xffff0000u); r[2] = __uint_as_float(w.y << 16); r[3] = __uint_as_float(w.y & 0xffff0000u); return r; }
__device__ __forceinline__ f32x4 ld4bf(const bf16_t* p) { const u32x2 w = *(const u32x2*)p; f32x4 r; r[0] = __uint_as_float(w.x << 16); r[1] = __uint_as_float(w.x & 0xffff0000u); r[2] = __uint_as_float(w.y << 16); r[3] = __uint_as_float(w.y & 0xffff0000u); return r; }
template <int MODE>
__device__ __forceinline__ void rowop_sample(int bx, int G, int wave, int lane, LAS unsigned char* lds, const float* SLAB, int nslab, const float* xs, float* H, const float* gpost, const float* gpre, bf16_t* XN, float* out) {
    LAS float* red = (LAS float*)lds;
    for (int r = bx; r < MS; r += G) {
        const int m = MP + r, c = wave * 256 + 4 * lane;
        f32x4 f = (f32x4){0.f, 0.f, 0.f, 0.f};
        for (int k = 0; k < nslab; ++k) f += *(const f32x4*)(SLAB + ((size_t)k * 128 + r) * DM + c);
        float s = wave_sum((f[0] * f[0] + f[1] * f[1]) + (f[2] * f[2] + f[3] * f[3]));
        if (lane == 0) red[wave] = s;
        __syncthreads();
        s = ((red[0] + red[1]) + (red[2] + red[3])) + ((red[4] + red[5]) + (red[6] + red[7]));
        const float rr = ((MODE == 1) ? 1.0f : 0.5f) / sqrtf(s * (1.0f / DM) + RMS_EPS);
        f32x4 bv;
        if (MODE == 0) bv = *(const f32x4*)(xs + (size_t)r * DM + c);
        else { const u32x2 hw = *(const u32x2*)((const bf16_t*)H + (size_t)m * DM + c); bv[0] = __uint_as_float(hw.x << 16); bv[1] = __uint_as_float(hw.x & 0xffff0000u); bv[2] = __uint_as_float(hw.y << 16); bv[3] = __uint_as_float(hw.y & 0xffff0000u); }
        const f32x4 gv = *(const f32x4*)(gpost + c);
        f = bv + f * rr * gv;
        if (MODE == 2) { *(f32x4*)(out + (size_t)m * DM + c) = f; }
        else {
            float s2 = wave_sum((f[0] * f[0] + f[1] * f[1]) + (f[2] * f[2] + f[3] * f[3]));
            if (lane == 0) red[8 + wave] = s2;
            __syncthreads();
            s2 = ((red[8] + red[9]) + (red[10] + red[11])) + ((red[12] + red[13]) + (red[14] + red[15]));
            const float r2 = 1.0f / sqrtf(s2 * (1.0f / DM) + RMS_EPS);
            { u32x2 hw; hw.x = cvt_pk_bf16(f[0], f[1]); hw.y = cvt_pk_bf16(f[2], f[3]); *(u32x2*)((bf16_t*)H + (size_t)m * DM + c) = hw; }
            const f32x4 gp = *(const f32x4*)(gpre + c); const f32x4 o = f * r2 * gp;
            u32x2 w; w.x = cvt_pk_bf16(o[0], o[1]); w.y = cvt_pk_bf16(o[2], o[3]); *(u32x2*)(XN + (size_t)m * DM + c) = w;
        }
        __syncthreads();
    }
}

constexpr int POOL_NCHUNK = 2048 + 512 + 240 + 960;
template <int W>
__device__ __forceinline__ void pool_item(const bf16_t* __restrict__ UP, bf16_t* __restrict__ DIFF, int m0, int t0, int c) {
    const bf16_t* base = UP + (size_t)m0 * PW + c;
    const bool first = (t0 == 0);
    u32x2 r[W + 15];
#pragma unroll
    for (int k = 0; k < W + 15; ++k) { const int dt = k - (W - 1); const bf16_t* a = (dt < 0 && first) ? base : base + (long)dt * PW; r[k] = *(const u32x2*)a; }
    __builtin_amdgcn_sched_barrier(0);
    if (first) {
#pragma unroll
        for (int k = 0; k < W - 1; ++k) r[k] = (u32x2){0u, 0u};
    }
    f32x4 sum = (f32x4){0.f, 0.f, 0.f, 0.f};
#pragma unroll
    for (int s = 1; s < W; ++s) sum += bf4(r[W - 1 - s]);
#pragma unroll
    for (int i = 0; i < 16; ++i) {
        const f32x4 uv = bf4(r[W - 1 + i]);
        sum += uv;
        const int t = t0 + i, cnt = (t + 1) < W ? (t + 1) : W;
        const f32x4 d = sum / (float)cnt - uv;
        u32x2 o; o.x = cvt_pk_bf16(d[0], d[1]); o.y = cvt_pk_bf16(d[2], d[3]); *(u32x2*)(DIFF + (size_t)(m0 + i) * PW + c) = o;
        sum -= bf4(r[i]);
    }
}
__device__ __forceinline__ void pool_chunk(int q, int lane, const float* UPf, const float* spool, bf16_t* DIFF, float* out_pp, float* out_ps) {
    const bf16_t* UP = (const bf16_t*)UPf;
    if (q < 2048) {
        const int idx = q * 64 + lane;
        const int c = (idx & 255) * 4, ch = idx >> 8, m0 = ch * 16, t0 = m0 & (SEQ - 1), grp = q & 3;
        if (grp == 0) pool_item<2>(UP, DIFF, m0, t0, c);
        else if (grp == 1) pool_item<4>(UP, DIFF, m0, t0, c);
        else if (grp == 2) pool_item<8>(UP, DIFF, m0, t0, c);
        else pool_item<16>(UP, DIFF, m0, t0, c);
    } else if (q < 2560) {
        const int idx = (q - 2048) * 64 + lane;
        const int c = (idx & 255) * 4, b = idx >> 8, w = 2 << (c >> 8);
        const f32x4 uv = ld4bf(UP + (size_t)(MP + b) * PW + c);
        f32x4 sum = uv;
        for (int e = 16 - w; e < 15; ++e) sum += *(const f32x4*)(spool + ((size_t)b * 15 + e) * PW + c);
        const f32x4 d = sum / (float)w - uv;
        u32x2 o; o.x = cvt_pk_bf16(d[0], d[1]); o.y = cvt_pk_bf16(d[2], d[3]); *(u32x2*)(DIFF + (size_t)(MP + b) * PW + c) = o;
    } else if (q < 2800) {
        const int idx = (q - 2560) * 64 + lane; const int c = (idx & 255) * 4, e = (idx >> 8) % 15, b = (idx >> 8) / 15;
        *(f32x4*)(out_pp + ((size_t)b * 15 + e) * PW + c) = ld4bf(UP + ((size_t)b * SEQ + (SEQ - 15) + e) * PW + c);
    } else {
        f32x4 v[8];
#pragma unroll
        for (int j = 0; j < 8; ++j) { const int idx = ((q - 2800) * 8 + j) * 64 + lane; const int c = (idx & 255) * 4, e = (idx >> 8) % 15, b = (idx >> 8) / 15;
            v[j] = (e < 14) ? *(const f32x4*)(spool + ((size_t)b * 15 + e + 1) * PW + c) : ld4bf(UP + (size_t)(MP + b) * PW + c); }
        __builtin_amdgcn_sched_barrier(0);
#pragma unroll
        for (int j = 0; j < 8; ++j) { const int idx = ((q - 2800) * 8 + j) * 64 + lane; const int c = (idx & 255) * 4, e = (idx >> 8) % 15, b = (idx >> 8) / 15;
            *(f32x4*)(out_ps + ((size_t)b * 15 + e) * PW + c) = v[j]; }
    }
}
__device__ __forceinline__ void pool_steal(int bx, int G, LAS unsigned* counter, int lane, const float* UPf, const float* spool, bf16_t* DIFF, float* out_pp, float* out_ps) {
    for (;;) {
        unsigned n = 0;
        if (lane == 0) n = __hip_atomic_fetch_add(counter, 1u, __ATOMIC_RELAXED, __HIP_MEMORY_SCOPE_WORKGROUP);
        n = (unsigned)__builtin_amdgcn_readfirstlane((int)n);
        const int q = bx + (int)n * G;
        if (q >= POOL_NCHUNK) break;
        pool_chunk(q, lane, UPf, spool, DIFF, out_pp, out_ps);
    }
}

__device__ __forceinline__ double dexp_small(double x) {
    const double z = x * (1.0 / 256.0); double term = 1.0, e = 1.0;
#pragma unroll
    for (int k = 1; k <= 12; ++k) { term *= z / (double)k; e += term; }
#pragma unroll
    for (int k = 0; k < 8; ++k) e = e * e;
    return e;
}
__device__ __forceinline__ void ssm_params(int g, int n, const float* a_re, const float* a_im, const float* log_step, const float* b_re, const float* b_im,
                                           float& lr, float& li, float& pr, float& pi, float (&bbr)[16], float (&bbi)[16], int nsq = 8) {
    const double dt = dexp_small((double)log_step[g]);
    const double ar = (double)a_re[g * 64 + n], ai = (double)a_im[g * 64 + n];
    const double mag = dexp_small(ar * dt);
    const double ang = ai * dt; const double TWO_PI = 6.283185307179586476925;
    const double r = ang - rint(ang / TWO_PI) * TWO_PI, r2 = r * r;
    double sn = r, cs = 1.0, ts = r, tc = 1.0;
#pragma unroll
    for (int k = 1; k <= 14; ++k) { tc *= -r2 / (double)((2 * k - 1) * (2 * k)); cs += tc; ts *= -r2 / (double)((2 * k) * (2 * k + 1)); sn += ts; }
    const double lbr = mag * cs, lbi = mag * sn;
    const double den = ar * ar + ai * ai, nre = lbr - 1.0;
    const double fre = (nre * ar + lbi * ai) / den, fim = (lbi * ar - nre * ai) / den;
    lr = (float)lbr; li = (float)lbi;
    double qr = lbr, qi = lbi;
#pragma unroll
    for (int k = 0; k < nsq; ++k) { const double t = qr * qr - qi * qi; qi = 2.0 * qr * qi; qr = t; }
    pr = (float)qr; pi = (float)qi;
    const float* br = b_re + (size_t)(g * 64 + n) * 16; const float* bi = b_im + (size_t)(g * 64 + n) * 16;
#pragma unroll
    for (int h4 = 0; h4 < 4; ++h4) { const f32x4 x = *(const f32x4*)(br + 4 * h4), y = *(const f32x4*)(bi + 4 * h4);
#pragma unroll
        for (int j = 0; j < 4; ++j) { bbr[4 * h4 + j] = (float)(fre * (double)x[j] - fim * (double)y[j]); bbi[4 * h4 + j] = (float)(fre * (double)y[j] + fim * (double)x[j]); } }
}
__device__ __forceinline__ void ssm_cfrag(int g, int lane, const float* c_re, const float* c_im, bf16x8 (&cf)[4]) {
    const int h = lane & 15, q4 = lane >> 4;
#pragma unroll
    for (int ks = 0; ks < 4; ++ks) {
        const f32x4 cr = *(const f32x4*)(c_re + (size_t)(g * 16 + h) * 64 + 16 * ks + 4 * q4), ci = *(const f32x4*)(c_im + (size_t)(g * 16 + h) * 64 + 16 * ks + 4 * q4);
        u32x4 w; w.x = cvt_pk_bf16(cr[0], -ci[0]); w.y = cvt_pk_bf16(cr[1], -ci[1]); w.z = cvt_pk_bf16(cr[2], -ci[2]); w.w = cvt_pk_bf16(cr[3], -ci[3]);
        cf[ks] = __builtin_bit_cast(bf16x8, w);
    }
}
constexpr int SSM_WSTRIDE = 23040;
#define SSM_STEP(UPTR) do { const f32x4 _u0 = *(const LAS f32x4*)(UPTR), _u1 = *(const LAS f32x4*)((UPTR) + 4), _u2 = *(const LAS f32x4*)((UPTR) + 8), _u3 = *(const LAS f32x4*)((UPTR) + 12); \
        float _r0 = bbr[0] * _u0[0], _r1 = bbr[1] * _u0[1], _i0 = bbi[0] * _u0[0], _i1 = bbi[1] * _u0[1]; \
        _r0 = fmaf(bbr[2], _u0[2], _r0); _r1 = fmaf(bbr[3], _u0[3], _r1); _i0 = fmaf(bbi[2], _u0[2], _i0); _i1 = fmaf(bbi[3], _u0[3], _i1); \
        _r0 = fmaf(bbr[4], _u1[0], _r0); _r1 = fmaf(bbr[5], _u1[1], _r1); _i0 = fmaf(bbi[4], _u1[0], _i0); _i1 = fmaf(bbi[5], _u1[1], _i1); \
        _r0 = fmaf(bbr[6], _u1[2], _r0); _r1 = fmaf(bbr[7], _u1[3], _r1); _i0 = fmaf(bbi[6], _u1[2], _i0); _i1 = fmaf(bbi[7], _u1[3], _i1); \
        _r0 = fmaf(bbr[8], _u2[0], _r0); _r1 = fmaf(bbr[9], _u2[1], _r1); _i0 = fmaf(bbi[8], _u2[0], _i0); _i1 = fmaf(bbi[9], _u2[1], _i1); \
        _r0 = fmaf(bbr[10], _u2[2], _r0); _r1 = fmaf(bbr[11], _u2[3], _r1); _i0 = fmaf(bbi[10], _u2[2], _i0); _i1 = fmaf(bbi[11], _u2[3], _i1); \
        _r0 = fmaf(bbr[12], _u3[0], _r0); _r1 = fmaf(bbr[13], _u3[1], _r1); _i0 = fmaf(bbi[12], _u3[0], _i0); _i1 = fmaf(bbi[13], _u3[1], _i1); \
        _r0 = fmaf(bbr[14], _u3[2], _r0); _r1 = fmaf(bbr[15], _u3[3], _r1); _i0 = fmaf(bbi[14], _u3[2], _i0); _i1 = fmaf(bbi[15], _u3[3], _i1); \
        const float _nr = fmaf(lr, xr, fmaf(-li, xi, _r0 + _r1)), _ni = fmaf(lr, xi, fmaf(li, xr, _i0 + _i1)); xr = _nr; xi = _ni; } while (0)

constexpr int SSM_NW = 4, SSM_CH = SEQ / SSM_NW, SSM_SUBS = SSM_CH / 64;
__device__ __forceinline__ void ssm_prompt_unit(int b, int g, const float* US, bf16_t* GS, float* out_re, float* out_im, const float* const* in, LAS unsigned char* lds, volatile LAS unsigned* flags, unsigned epoch, int wave, int lane) {
    float lr, li, pr, pi;
    LAS float* ub = (LAS float*)(lds + wave * SSM_WSTRIDE);
    LAS unsigned* xt = (LAS unsigned*)(lds + wave * SSM_WSTRIDE + 8192);
    LAS float* but = (LAS float*)(lds + wave * SSM_WSTRIDE + 12544);
    volatile LAS float* sb = (volatile LAS float*)(lds + SSM_NW * SSM_WSTRIDE);
    const int l15 = lane & 15, q4 = lane >> 4;
    bf16x8 bfr[8];
    {
        float bbr[16], bbi[16];
        ssm_params(g, lane, in[I_ARE], in[I_AIM], in[I_LOGSTEP], in[I_BRE], in[I_BIM], lr, li, pr, pi, bbr, bbi, 9);
        LAS unsigned* tb = (LAS unsigned*)but;
#pragma unroll
        for (int k = 0; k < 8; ++k) { tb[lane * 8 + k] = cvt_pk_bf16(bbr[2 * k], bbr[2 * k + 1]); tb[(64 + lane) * 8 + k] = cvt_pk_bf16(bbi[2 * k], bbi[2 * k + 1]); }
        LDS_WAIT();
#pragma unroll
        for (int nb = 0; nb < 8; ++nb) { u32x4 w = (u32x4){0u, 0u, 0u, 0u}; if (q4 < 2) w = *(const LAS u32x4*)(tb + (16 * nb + l15) * 8 + 4 * q4); bfr[nb] = __builtin_bit_cast(bf16x8, w); }
        LDS_WAIT();
    }
    const size_t row0 = (size_t)b * SEQ + (size_t)wave * SSM_CH;
    const bf16_t* up = (const bf16_t*)US + us_off(row0, g * 16);
    u32x2 pk[SSM_SUBS][4];
#pragma unroll
    for (int _s = 0; _s < SSM_SUBS; ++_s)
#pragma unroll
        for (int _i = 0; _i < 4; ++_i) { const int _p = _i * 64 + lane; pk[_s][_i] = *(const u32x2*)(up + (size_t)(_s * 64 + (_p >> 2)) * 16 + (_p & 3) * 4); }
#define SSM_STOREU(buf, sub) do { _Pragma("unroll") for (int _i = 0; _i < 4; ++_i) *(LAS f32x4*)(ub + (buf) * 1024 + (_i * 64 + lane) * 4) = bf4(pk[sub][_i]); } while (0)
#define SSM_TILE_BU(UT) \
        f32x4 bre[4], bim[4]; \
        { u32x4 uw = (u32x4){0u, 0u, 0u, 0u}; \
          if (q4 < 2) { const f32x4 ua = *(const LAS f32x4*)((UT) + l15 * 16 + 8 * q4), ubv = *(const LAS f32x4*)((UT) + l15 * 16 + 8 * q4 + 4); \
              uw.x = cvt_pk_bf16(ua[0], ua[1]); uw.y = cvt_pk_bf16(ua[2], ua[3]); uw.z = cvt_pk_bf16(ubv[0], ubv[1]); uw.w = cvt_pk_bf16(ubv[2], ubv[3]); } \
          const bf16x8 uf = __builtin_bit_cast(bf16x8, uw); \
          _Pragma("unroll") for (int nb = 0; nb < 8; ++nb) { const f32x4 d = __builtin_amdgcn_mfma_f32_16x16x32_bf16(uf, bfr[nb], (f32x4){0.f, 0.f, 0.f, 0.f}, 0, 0, 0); \
              *(LAS f32x4*)(but + (16 * nb + l15) * 20 + 4 * q4) = d; } \
          _Pragma("unroll") for (int k = 0; k < 4; ++k) { bre[k] = *(const LAS f32x4*)(but + lane * 20 + 4 * k); bim[k] = *(const LAS f32x4*)(but + (64 + lane) * 20 + 4 * k); } }
#define SSM_UPD(tt) do { const float _br = bre[(tt) >> 2][(tt) & 3], _bi = bim[(tt) >> 2][(tt) & 3]; \
        const float _nr = fmaf(lr, xr, fmaf(-li, xi, _br)), _ni = fmaf(lr, xi, fmaf(li, xr, _bi)); xr = _nr; xi = _ni; } while (0)
    float xr = 0.f, xi = 0.f;
    SSM_STOREU(0, 0);
#pragma unroll
    for (int sub = 0; sub < SSM_SUBS; ++sub) {
        const LAS float* u = ub + (sub & 1) * 1024;
        if (sub < SSM_SUBS - 1) SSM_STOREU((sub + 1) & 1, sub + 1);
_Pragma("unroll 1")
        for (int tile = 0; tile < 4; ++tile) {
            SSM_TILE_BU(u + tile * 256);
#pragma unroll
            for (int tt = 0; tt < 16; ++tt) SSM_UPD(tt);
        }
    }
    if (epoch > 1u) for (int j = 0; j < SSM_NW; ++j) while (flags[4 + j] != epoch - 1u) __builtin_amdgcn_s_sleep(1);
    sb[(wave * 64 + lane) * 2] = xr; sb[(wave * 64 + lane) * 2 + 1] = xi;
    LDS_WAIT();
    __builtin_amdgcn_fence(__ATOMIC_RELEASE, "workgroup");
    if (lane == 0) flags[wave] = epoch;
    float cr = 0.f, ci = 0.f;
    for (int j = 0; j < wave; ++j) {
        while (flags[j] != epoch) __builtin_amdgcn_s_sleep(1);
        __builtin_amdgcn_fence(__ATOMIC_ACQUIRE, "workgroup");
        const float sr = sb[(j * 64 + lane) * 2], si = sb[(j * 64 + lane) * 2 + 1];
        const float nr = pr * cr - pi * ci + sr, ni = pr * ci + pi * cr + si; cr = nr; ci = ni; }
    if (lane == 0) flags[4 + wave] = epoch;
    bf16x8 cf[4]; ssm_cfrag(g, lane, in[I_CRE], in[I_CIM], cf);
    const int h = l15, tq = q4;
    const float dsk = in[I_SSMD][g * 16 + h];
    xr = cr; xi = ci;
    SSM_STOREU(0, 0);
#pragma unroll
    for (int sub = 0; sub < SSM_SUBS; ++sub) {
        const LAS float* u = ub + (sub & 1) * 1024;
        if (sub < SSM_SUBS - 1) SSM_STOREU((sub + 1) & 1, sub + 1);
_Pragma("unroll 1")
        for (int tile = 0; tile < 4; ++tile) {
            SSM_TILE_BU(u + tile * 256);
#pragma unroll
            for (int tt = 0; tt < 16; ++tt) { SSM_UPD(tt); xt[tt * 68 + lane] = cvt_pk_bf16(xr, xi); }
            f32x4 acc = (f32x4){0.f, 0.f, 0.f, 0.f};
#pragma unroll
            for (int ks = 0; ks < 4; ++ks) { const bf16x8 a = *(const LAS bf16x8*)(xt + h * 68 + 4 * tq + 16 * ks); acc = __builtin_amdgcn_mfma_f32_16x16x32_bf16(a, cf[ks], acc, 0, 0, 0); }
#pragma unroll
            for (int r = 0; r < 4; ++r) { const int tl = tile * 16 + 4 * tq + r; const float y = acc[r] + dsk * u[tl * 16 + h];
                GS[(row0 + sub * 64 + tl) * 1024 + g * 16 + h] = (bf16_t)(cvt_pk_bf16(gelu_tanh(y), 0.f) & 0xffff); }
        }
    }
    if (wave == SSM_NW - 1) { out_re[(size_t)(b * 64 + g) * 64 + lane] = xr; out_im[(size_t)(b * 64 + g) * 64 + lane] = xi; }
#undef SSM_STOREU
#undef SSM_TILE_BU
#undef SSM_UPD
}
__device__ __forceinline__ void ssm_sample_unit(int g, int bq, const float* US, bf16_t* GS, const float* st_re, const float* st_im, float* out_re, float* out_im, const float* const* in,
                                                LAS unsigned char* lds, int wave, int lane) {
    float lr, li, pr, pi; float bbr[16], bbi[16];
    ssm_params(g, lane, in[I_ARE], in[I_AIM], in[I_LOGSTEP], in[I_BRE], in[I_BIM], lr, li, pr, pi, bbr, bbi);
    LAS float* ub = (LAS float*)(lds + wave * SSM_WSTRIDE);
    LAS unsigned* xt = (LAS unsigned*)(lds + wave * SSM_WSTRIDE + 8192);
    { const int i = lane >> 2, part = lane & 3; *(LAS f32x4*)(ub + lane * 4) = ld4bf((const bf16_t*)US + us_off((size_t)(MP + bq * 16 + i), g * 16 + part * 4)); }
    for (int i = 0; i < 16; ++i) {
        const int b = bq * 16 + i; const size_t so = (size_t)(b * 64 + g) * 64 + lane;
        float xr = st_re[so], xi = st_im[so];
        SSM_STEP(ub + i * 16);
        out_re[so] = xr; out_im[so] = xi;
        xt[i * 68 + lane] = cvt_pk_bf16(xr, xi);
    }
    bf16x8 cf[4]; ssm_cfrag(g, lane, in[I_CRE], in[I_CIM], cf);
    const int h = lane & 15, tq = lane >> 4;
    const float dsk = in[I_SSMD][g * 16 + h];
    f32x4 acc = (f32x4){0.f, 0.f, 0.f, 0.f};
#pragma unroll
    for (int ks = 0; ks < 4; ++ks) { const bf16x8 a = *(const LAS bf16x8*)(xt + h * 68 + 4 * tq + 16 * ks); acc = __builtin_amdgcn_mfma_f32_16x16x32_bf16(a, cf[ks], acc, 0, 0, 0); }
#pragma unroll
    for (int r = 0; r < 4; ++r) { const int i = 4 * tq + r; const float y = acc[r] + dsk * ub[i * 16 + h];
        GS[(size_t)(MP + bq * 16 + i) * 1024 + g * 16 + h] = (bf16_t)(cvt_pk_bf16(gelu_tanh(y), 0.f) & 0xffff); }
}

__device__ __forceinline__ void attn_load_img(LAS unsigned char* img, const bf16_t* base, int row_stride, int tid) {
#pragma unroll 4
    for (int it = 0; it < 16; ++it) { const int cidx = it * NTHREADS + tid, row = cidx >> 5, c16 = cidx & 31;
        const u32x4 v = *(const u32x4*)(base + (size_t)row * row_stride + c16 * 8);
        *(LAS u32x4*)(img + row * 512 + ((c16 ^ (row & 15)) << 4)) = v; }
}
__device__ __forceinline__ void attn_prompt_unit(int b, int hd, int qb, const bf16_t* Q, const bf16_t* KB, const bf16_t* VT, bf16_t* XO, LAS unsigned char* lds, int tid, int wave, int lane) {
    const int l15 = lane & 15, h4 = lane >> 4;
    const size_t qrow = (size_t)b * SEQ + qb * 128 + wave * 16 + l15;
    bf16x8 qf[8];
#pragma unroll
    for (int ks = 0; ks < 8; ++ks) qf[ks] = *(const bf16x8*)(Q + qrow * 1024 + hd * 256 + 32 * ks + 8 * h4);
    attn_load_img(lds, KB + (size_t)b * NMEM * 1024 + hd * 256, 1024, tid);
    __syncthreads();
    f32x4 sa[16];
#pragma unroll
    for (int nb = 0; nb < 16; ++nb) {
        f32x4 acc = (f32x4){0.f, 0.f, 0.f, 0.f};
#pragma unroll
        for (int ks = 0; ks < 8; ++ks) { const bf16x8 a = *(const LAS bf16x8*)(lds + (16 * nb + l15) * 512 + (((4 * ks + h4) ^ l15) << 4));
            acc = __builtin_amdgcn_mfma_f32_16x16x32_bf16(a, qf[ks], acc, 0, 0, 0); }
        sa[nb] = acc;
    }
    float mx = -3.0e38f;
#pragma unroll
    for (int nb = 0; nb < 16; ++nb) mx = fmaxf(fmaxf(mx, fmaxf(sa[nb][0], sa[nb][1])), fmaxf(sa[nb][2], sa[nb][3]));
    mx = fmaxf(mx, __shfl_xor(mx, 16)); mx = fmaxf(mx, __shfl_xor(mx, 32));
    float sum = 0.f;
#pragma unroll
    for (int nb = 0; nb < 16; ++nb) {
#pragma unroll
        for (int r = 0; r < 4; ++r) { const float p = __expf(sa[nb][r] - mx); sa[nb][r] = p; sum += p; } }
    sum += __shfl_xor(sum, 16); sum += __shfl_xor(sum, 32);
    const float inv = 1.0f / sum;
    bf16x8 pf[8];
#pragma unroll
    for (int ks = 0; ks < 8; ++ks) { u32x4 w; w.x = cvt_pk_bf16(sa[2 * ks][0], sa[2 * ks][1]); w.y = cvt_pk_bf16(sa[2 * ks][2], sa[2 * ks][3]);
        w.z = cvt_pk_bf16(sa[2 * ks + 1][0], sa[2 * ks + 1][1]); w.w = cvt_pk_bf16(sa[2 * ks + 1][2], sa[2 * ks + 1][3]); pf[ks] = __builtin_bit_cast(bf16x8, w); }
    __syncthreads();
    attn_load_img(lds, VT + (size_t)(b * 4 + hd) * 256 * 256, 256, tid);
    __syncthreads();
#pragma unroll
    for (int db = 0; db < 16; ++db) {
        f32x4 acc = (f32x4){0.f, 0.f, 0.f, 0.f};
#pragma unroll
        for (int ks = 0; ks < 8; ++ks) {
            const LAS unsigned char* rp = lds + (16 * db + l15) * 512;
            const u32x2 lo = *(const LAS u32x2*)(rp + (((8 * ks + h4) ^ (l15 << 1)) << 3)), hi = *(const LAS u32x2*)(rp + (((8 * ks + 4 + h4) ^ (l15 << 1)) << 3));
            u32x4 w; w.x = lo.x; w.y = lo.y; w.z = hi.x; w.w = hi.y;
            acc = __builtin_amdgcn_mfma_f32_16x16x32_bf16(__builtin_bit_cast(bf16x8, w), pf[ks], acc, 0, 0, 0);
        }
        u32x2 o; o.x = cvt_pk_bf16(acc[0] * inv, acc[1] * inv); o.y = cvt_pk_bf16(acc[2] * inv, acc[3] * inv);
        *(u32x2*)(XO + qrow * 1024 + hd * 256 + 16 * db + 4 * h4) = o;
    }
    __syncthreads();
}
__device__ __forceinline__ float red16(float (&p)[16], int lane) {
#pragma unroll
    for (int k = 0; k < 8; ++k) { const float a = p[k], b = p[k + 8]; const float snd = (lane & 32) ? a : b, keep = (lane & 32) ? b : a; p[k] = keep + __shfl_xor(snd, 32); }
#pragma unroll
    for (int k = 0; k < 4; ++k) { const float a = p[k], b = p[k + 4]; const float snd = (lane & 16) ? a : b, keep = (lane & 16) ? b : a; p[k] = keep + __shfl_xor(snd, 16); }
#pragma unroll
    for (int k = 0; k < 2; ++k) { const float a = p[k], b = p[k + 2]; const float snd = (lane & 8) ? a : b, keep = (lane & 8) ? b : a; p[k] = keep + __shfl_xor(snd, 8); }
    { const float a = p[0], b = p[1]; const float snd = (lane & 4) ? a : b, keep = (lane & 4) ? b : a; p[0] = keep + __shfl_xor(snd, 4); }
    float r = p[0]; r += __shfl_xor(r, 2); r += __shfl_xor(r, 1);
    return r;
}
__device__ __forceinline__ void attn_sample_half(int b, int hd, int kh, int rot, const bf16_t* Q, const float* CK, const float* CV, bf16_t* XO, LAS float* xch, volatile LAS unsigned* flag, unsigned epoch, int lane) {
    f32x4 q4; { const u32x2 qv = *(const u32x2*)(Q + (size_t)(MP + b) * 1024 + hd * 256 + 4 * lane);
        q4[0] = __uint_as_float(qv.x << 16); q4[1] = __uint_as_float(qv.x & 0xffff0000u); q4[2] = __uint_as_float(qv.y << 16); q4[3] = __uint_as_float(qv.y & 0xffff0000u); }
    const float* kbase = CK + ((size_t)b * NMEM * 4 + hd) * 256 + 4 * lane + (size_t)(kh * 128) * 1024;
    const float* vbase = CV + ((size_t)b * NMEM * 4 + hd) * 256 + 4 * lane + (size_t)(kh * 128) * 1024;
    float sc[8];
#pragma unroll
    for (int i = 0; i < 8; ++i) {
        const int bt = (i + rot) & 7;
        f32x4 kv[16];
#pragma unroll
        for (int j = 0; j < 16; ++j) kv[j] = __builtin_nontemporal_load((const f32x4*)(kbase + (size_t)(bt * 16 + j) * 1024));
        float p[16];
#pragma unroll
        for (int j = 0; j < 16; ++j) p[j] = (kv[j][0] * q4[0] + kv[j][1] * q4[1]) + (kv[j][2] * q4[2] + kv[j][3] * q4[3]);
        sc[i] = red16(p, lane);
    }
    float mx = sc[0];
#pragma unroll
    for (int i = 1; i < 8; ++i) mx = fmaxf(mx, sc[i]);
    mx = wave_max(mx);
    float sum = 0.f;
#pragma unroll
    for (int i = 0; i < 8; ++i) { sc[i] = __expf(sc[i] - mx); sum += sc[i]; }
    sum = wave_sum(sum) * 0.25f;
    f32x4 o = (f32x4){0.f, 0.f, 0.f, 0.f};
#pragma unroll
    for (int i = 0; i < 8; ++i) {
        const int bt = (i + rot) & 7;
        f32x4 vv[16];
#pragma unroll
        for (int j = 0; j < 16; ++j) vv[j] = __builtin_nontemporal_load((const f32x4*)(vbase + (size_t)(bt * 16 + j) * 1024));
#pragma unroll
        for (int j = 0; j < 16; ++j) { const float pj = __shfl(sc[i], 4 * j); o += vv[j] * pj; }
    }
    if (kh == 1) {
        if (epoch > 1u) while (flag[4] != epoch - 1u) __builtin_amdgcn_s_sleep(1);
        *(LAS f32x4*)(xch + 4 * lane) = o; if (lane == 0) { xch[256] = mx; xch[257] = sum; }
        LDS_WAIT();
        __builtin_amdgcn_fence(__ATOMIC_RELEASE, "workgroup");
        if (lane == 0) *flag = epoch;
    } else {
        while (*flag != epoch) __builtin_amdgcn_s_sleep(1);
        __builtin_amdgcn_fence(__ATOMIC_ACQUIRE, "workgroup");
        const volatile LAS float* xv = xch;
        const float mB = xv[256], lB = xv[257];
        f32x4 oB; oB[0] = xv[4 * lane]; oB[1] = xv[4 * lane + 1]; oB[2] = xv[4 * lane + 2]; oB[3] = xv[4 * lane + 3];
        const float M = fmaxf(mx, mB), fa = __expf(mx - M), fb = __expf(mB - M);
        const float inv = 1.0f / (sum * fa + lB * fb);
        o = (o * fa + oB * fb) * inv;
        u32x2 w; w.x = cvt_pk_bf16(o[0], o[1]); w.y = cvt_pk_bf16(o[2], o[3]);
        *(u32x2*)(XO + (size_t)(MP + b) * 1024 + hd * 256 + 4 * lane) = w;
        if (lane == 0) flag[4] = epoch;
    }
}

#define XB_TMO      128
#define XB_XCNT(j)  (256  + 64 * (j))
#define XB_XSUB(j)  (1280 + 64 * (j))
#define XB_XGEN(j)  (2304 + 64 * (j))
#define XB_TOP      3328
#define XB_TOPGEN   3392
#define XCD_BAR_WORDS 3456
#define XB_SPIN_CAP (1u << 18)
__device__ __forceinline__ unsigned xb_ld(unsigned* p)              { return __hip_atomic_load(p, __ATOMIC_RELAXED, __HIP_MEMORY_SCOPE_AGENT); }
__device__ __forceinline__ unsigned xb_add(unsigned* p, unsigned v) { return __hip_atomic_fetch_add(p, v, __ATOMIC_RELAXED, __HIP_MEMORY_SCOPE_AGENT); }
__device__ __forceinline__ unsigned xb_xcc_id() { return (unsigned)__builtin_amdgcn_s_getreg((3 << 11) | 20) & 0xFu; }
#define XB_SPIN(cond, bar) do { unsigned _sp = 0; while (cond) { __builtin_amdgcn_s_sleep(1); \
    if ((++_sp & 255u) == 0u) { if (xb_ld(&(bar)[XB_TMO])) break; if (_sp > XB_SPIN_CAP) { atomicAdd(&(bar)[XB_TMO], 1u); break; } } } } while (0)
struct XcdBarrier { unsigned* bar; unsigned x; volatile LAS unsigned* st; };
__device__ __forceinline__ XcdBarrier xcd_barrier_post(unsigned* bar, volatile LAS unsigned* st) {
    XcdBarrier b; b.bar = bar; b.x = xb_xcc_id(); b.st = st;
    if (threadIdx.x == 0) (void)xb_add(&bar[XB_XCNT(b.x)], 1u);
    return b;
}
__device__ __forceinline__ void xcd_barrier_complete(unsigned* bar, unsigned x, unsigned& nloc, unsigned& nx) {
    const unsigned G = gridDim.x * gridDim.y * gridDim.z;
    unsigned sum, cnt, mine, sp = 0u;
    for (;;) {
        sum = 0u; cnt = 0u; mine = 0u;
#pragma unroll
        for (unsigned j = 0; j < 16; ++j) { const unsigned c = xb_ld(&bar[XB_XCNT(j)]); sum += c; cnt += (c > 0u) ? 1u : 0u; mine = (j == x) ? c : mine; }
        if (sum == G) break;
        __builtin_amdgcn_s_sleep(1);
        if ((++sp & 255u) == 0u) { if (xb_ld(&bar[XB_TMO])) break; if (sp > XB_SPIN_CAP) { atomicAdd(&bar[XB_TMO], 1u); break; } }
    }
    nloc = mine > 0u ? mine : 1u; nx = cnt > 0u ? cnt : 1u;
}
__device__ __forceinline__ void xcd_barrier(const XcdBarrier& b) {
    asm volatile("s_waitcnt vmcnt(0)" ::: "memory");
    __syncthreads();
    if (threadIdx.x == 0) {
        unsigned* bar = b.bar;
        __builtin_amdgcn_s_waitcnt(0);
        unsigned nloc = b.st[0], nx = b.st[1];
        if (nloc == 0u) { xcd_barrier_complete(bar, b.x, nloc, nx); b.st[0] = nloc; b.st[1] = nx; }
        const unsigned old = xb_add(&bar[XB_XSUB(b.x)], 1u);
        const unsigned gen = old / nloc;
        if (old + 1u == (gen + 1u) * nloc) {
            __builtin_amdgcn_fence(__ATOMIC_RELEASE, "agent");
            asm volatile("s_waitcnt vmcnt(0)" ::: "memory");
            const unsigned og = xb_add(&bar[XB_TOP], 1u);
            const unsigned tg = og / nx;
            if (og + 1u == (tg + 1u) * nx) xb_add(&bar[XB_TOPGEN], 1u);
            else XB_SPIN(xb_ld(&bar[XB_TOPGEN]) == tg, bar);
            xb_add(&bar[XB_XGEN(b.x)], 1u);
            __builtin_amdgcn_fence(__ATOMIC_ACQUIRE, "agent");
            asm volatile("s_waitcnt vmcnt(0)" ::: "memory");
        } else {
            asm volatile("buffer_inv sc1" ::: "memory");
            XB_SPIN(xb_ld(&bar[XB_XGEN(b.x)]) == gen, bar);
            asm volatile("s_waitcnt vmcnt(0)" ::: "memory");
        }
    }
    __syncthreads();
}
__device__ __forceinline__ void wait_count(unsigned* ctr, unsigned target) {
    if (threadIdx.x == 0) { unsigned sp = 0; while (xb_ld(ctr) < target) { __builtin_amdgcn_s_sleep(1); if (++sp > (1u << 22)) break; }
        __builtin_amdgcn_fence(__ATOMIC_ACQUIRE, "agent"); asm volatile("s_waitcnt vmcnt(0)" ::: "memory"); }
    __syncthreads();
}
constexpr int MISC_OFF = LDS_BYTES - 128;
constexpr size_t CTL_ZERO_BYTES = 65536;
constexpr int CW_BAR = 1024;
constexpr int CW_P8 = 9216;

__global__ void __launch_bounds__(NTHREADS, 2) mk_fwd(Args args) {
    extern __shared__ __attribute__((aligned(16))) unsigned char lds_raw[];
    LAS unsigned char* lds = (LAS unsigned char*)lds_raw;
    const int tid = threadIdx.x, lane = tid & 63, wave = __builtin_amdgcn_readfirstlane(tid >> 6);
    const int G = gridDim.x, bx = blockIdx.x;
    const int gw = bx * NWAVES + wave, ngw = G * NWAVES;
    const int gtid = bx * NTHREADS + tid, ngt = G * NTHREADS;
    unsigned char* ws = args.ws;
    const float* const* in = args.in;
    float* out = args.out;
    bf16_t* W1GU = (bf16_t*)(ws + WS_W1GU); bf16_t* W1D = (bf16_t*)(ws + WS_W1D); bf16_t* WIN = (bf16_t*)(ws + WS_WIN); bf16_t* WPG = (bf16_t*)(ws + WS_WPG);
    bf16_t* WPO = (bf16_t*)(ws + WS_WPO); bf16_t* WGLU = (bf16_t*)(ws + WS_WGLU); bf16_t* WXO = (bf16_t*)(ws + WS_WXO); bf16_t* WOUT = (bf16_t*)(ws + WS_WOUT);
    bf16_t* WMKV = (bf16_t*)(ws + WS_WMKV); bf16_t* W2GU = (bf16_t*)(ws + WS_W2GU); bf16_t* W2D = (bf16_t*)(ws + WS_W2D);
    bf16_t* XN = (bf16_t*)(ws + WS_XN); bf16_t* ACT = (bf16_t*)(ws + WS_ACT); bf16_t* GT = (bf16_t*)(ws + WS_ACT); float* F = (float*)(ws + WS_F); float* H = (float*)(ws + WS_H);
    float* UP = (float*)(ws + WS_UP); float* US = (float*)(ws + WS_US); bf16_t* Q = (bf16_t*)(ws + WS_Q); bf16_t* DIFF = (bf16_t*)(ws + WS_DIFF); bf16_t* WPO2 = (bf16_t*)(ws + WS_Z); bf16_t* WPGS = (bf16_t*)(ws + WS_Z + 8 * MiB); bf16_t* WPGO = (bf16_t*)(ws + WS_Z + 12 * MiB);
    bf16_t* GS = (bf16_t*)(ws + WS_GS); bf16_t* XO = (bf16_t*)(ws + WS_XO); bf16_t* MB = (bf16_t*)(ws + WS_MB); bf16_t* MEMN = (bf16_t*)(ws + WS_MEMN);
    bf16_t* KB = (bf16_t*)(ws + WS_KB); bf16_t* VT = (bf16_t*)(ws + WS_VT); float* SLAB = (float*)(ws + WS_SLAB); float* SLAB7 = (float*)(ws + WS_SLAB7);
    const int lo = args.ph_lo, hi = args.ph_hi;
    LAS float* scr = (LAS float*)(lds + wave * 16640);
    constexpr int IT_GU = (DM / 64) * (DFF / 64), IT_D = IT_GU, IT_IN = (DM / 64) * (9216 / 64), IT_IN_P0 = 2816, IT_PG = 16, IT_1K2K = (1024 / 64) * (2048 / 64), IT_2K1K = IT_1K2K, IT_OUT = 32 * 32;
#define TAIL_BEGIN(units) { const int busy_ = (units) % G; if (bx >= busy_) { const int tw = (bx - busy_) * NWAVES + wave, ntw = (G - busy_) * NWAVES;
#define TAIL_END } }
#if MK_SINGLE
    for (int i = tid; i < LDS_BYTES / 16; i += NTHREADS) ((LAS u32x4*)lds)[i] = (u32x4){0u, 0u, 0u, 0u};
    __syncthreads();
    const XcdBarrier xbar = xcd_barrier_post((unsigned*)ws + CW_BAR, (volatile LAS unsigned*)(lds + MISC_OFF) + 8);
#define GRID_BAR() xcd_barrier(xbar)
#else
#define GRID_BAR() do { } while (0)
#endif
#define IN(k) (lo <= (k) && (k) < hi)
#define SEAM(k) do { if (IN(k) && IN((k) + 1)) GRID_BAR(); } while (0)

    if (IN(0)) {
        constexpr int NITEMS = 2 * IT_GU + IT_IN_P0 + 2 * IT_2K1K;
        for (int it = gw; it < NITEMS; it += ngw) {
            int r = it;
            if (cvt_mat(r, in[I_W1G], DM, DFF, W1GU, 1, 0, scr, lane)) continue;
            if (cvt_mat(r, in[I_W1U], DM, DFF, W1GU, 1, 128, scr, lane)) continue;
            if (cvt_mat(r, in[I_WMK], DM, 1024, WMKV, 0, 0, scr, lane)) continue;
            if (cvt_mat(r, in[I_WMV], DM, 1024, WMKV, 0, 1024, scr, lane)) continue;
            cvt_mat(r, in[I_WIN], DM, 9216, WIN, 0, 0, scr, lane);
        }
        for (int m = gw; m < MT; m += ngw) rms_row_bf16(xrow_ptr(in[I_XP], in[I_XS], m), in[I_G1PRE], XN + (size_t)m * DM, lane);
        for (int m = gw; m < MEMR; m += ngw) rms_row_bf16(in[I_MEM] + (size_t)m * DM, in[I_GMEM], MEMN + (size_t)m * DM, lane);
    }
    SEAM(0);
    if (IN(1)) {
        pg8::Sched2 S; S.A0 = (const char*)XN; S.B0 = (const char*)W1GU; S.nM0 = NMT; S.nN0 = 2 * DFF / 256; S.nt0 = DM / 64; S.ta0 = (size_t)256 * DM * 2; S.tb0 = (size_t)256 * DM * 2; S.ca0 = 0;
        S.A1 = (const char*)MEMN; S.B1 = (const char*)WMKV; S.nM1 = MEMR / 256; S.nN1 = 8; S.nt1 = DM / 64; S.ta1 = (size_t)256 * DM * 2; S.tb1 = (size_t)256 * DM * 2; S.ca1 = 0; S.G = G; S.c = bx;
        pg8::EpiUp E; E.ACT = ACT; E.outK = out + O_MK; E.outV = out + O_MV; E.KB = KB; E.VT = VT;
        pg8::gemm_phase(lds, DM, DM, S, E);
        TAIL_BEGIN(NMT * (2 * DFF / 256) + (MEMR / 256) * 8)
            for (int it = tw; it < IT_D + (IT_IN - IT_IN_P0); it += ntw) { int r = it;
                if (cvt_mat<64>(r, in[I_W1D], DFF, DM, W1D, 0, 0, scr, lane)) continue;
                r += IT_IN_P0; cvt_mat<64>(r, in[I_WIN], DM, 9216, WIN, 0, 0, scr, lane); }
        TAIL_END
    }
    SEAM(1);
    if (IN(2)) {
        pg8::SchedN2 S; S.A = (const char*)ACT; S.B = (const char*)W1D; S.nt = DFF / 64; S.ta = (size_t)256 * DFF * 2; S.tb = (size_t)256 * DFF * 2; S.G = G; S.c = bx; S.minis = true;
        pg8::EpiF32 E; E.F = F; E.SLAB = SLAB;
        pg8::gemm_phase(lds, DFF, DFF, S, E);
        TAIL_BEGIN(256 + 8 * (DFF / 256))
            constexpr int NIT = 2 * IT_1K2K;
            for (int it = tw; it < NIT; it += ntw) {
                int r = it;
                if (cvt_mat<64>(r, in[I_WPO], 1024, DM, WPO2, 0, 0, scr, lane, DM)) continue;
                cvt_mat<64>(r, in[I_WXO], 1024, DM, WXO, 0, 0, scr, lane);
            }
            for (int q = tw * 64 + lane; q < 4 * 256 * 32; q += ntw * 64) {
                const int row = q >> 5, d0 = (q & 31) * 8; const float* wp = in[I_WPG] + (size_t)row * 256 + d0; const float* sp = in[I_PSCALE] + (row >> 8) * 256 + d0;
                *(u32x4*)(WPGS + (size_t)row * DM + d0) = pg8::pack8(*(const f32x4*)wp * *(const f32x4*)sp, *(const f32x4*)(wp + 4) * *(const f32x4*)(sp + 4));
            }
        TAIL_END
    }
    SEAM(2);
    if (IN(3)) { rowop_sample<0>(bx, G, wave, lane, lds, SLAB, DFF / 256, in[I_XS], H, in[I_G1POST], in[I_GMIXPRE], XN, nullptr);
        rowop<0>(gw, ngw, lane, F, SLAB, DFF / 256, in[I_XP], in[I_XS], H, in[I_G1POST], in[I_GMIXPRE], XN, nullptr); }
    SEAM(3);
    if (IN(4)) {
        pg8::Sched2 S; S.A0 = (const char*)XN; S.B0 = (const char*)WIN; S.nM0 = NMT; S.nN0 = 36; S.nt0 = DM / 64; S.ta0 = (size_t)256 * DM * 2; S.tb0 = (size_t)256 * DM * 2; S.ca0 = 0;
        S.A1 = (const char*)WPO2; S.B1 = (const char*)WPGS; S.nM1 = 8; S.nN1 = 4; S.nt1 = 4; S.ta1 = (size_t)256 * DM * 2; S.tb1 = (size_t)256 * DM * 2; S.ca1 = 512; S.G = G; S.c = bx;
        pg8::EpiIn E; E.UP = UP; E.US = US; E.Q = Q; E.G = GT; E.WPGO = WPGO;
        pg8::gemm_phase(lds, DM, DM, S, E);
        TAIL_BEGIN(NMT * 36)
            constexpr int NIT = 2 * IT_1K2K + IT_OUT + IT_GU;
            for (int it = tw; it < NIT; it += ntw) {
                int r = it;
                if (cvt_mat<64>(r, in[I_WGV], 1024, DM, WGLU, 1, 0, scr, lane)) continue;
                if (cvt_mat<64>(r, in[I_WGG], 1024, DM, WGLU, 1, 128, scr, lane)) continue;
                if (cvt_mat<64>(r, in[I_WOUT], DM, DM, WOUT, 0, 0, scr, lane)) continue;
                cvt_mat<64>(r, in[I_W2G], DM, DFF, W2GU, 1, 0, scr, lane);
            }
        TAIL_END
    }
    SEAM(4);
    if (IN(5)) {
        LAS unsigned* MISCW = (LAS unsigned*)(lds + MISC_OFF);
        if (wave < SSM_NW) {
            volatile LAS unsigned* flags = (volatile LAS unsigned*)MISCW + 16;
            unsigned epoch = 1;
            for (int un = bx; un < NBAT * 64; un += G, ++epoch) ssm_prompt_unit(un >> 6, un & 63, US, GS, out + O_SRP, out + O_SIP, in, lds, flags, epoch, wave, lane);
            for (int un = bx * SSM_NW + wave; un < 64 * 8; un += G * SSM_NW) ssm_sample_unit(un >> 3, un & 7, US, GS, in[I_SRE], in[I_SIM], out + O_SRS, out + O_SIS, in, lds, wave, lane);
        } else {
            const int pr = (wave - 4) >> 1, kh = (wave - 4) & 1;
            LAS float* xch = (LAS float*)(lds + 98304 + pr * 2048);
            unsigned epoch = 1;
            for (int un = bx * 2 + pr; un < MS * 4; un += G * 2, ++epoch)
                attn_sample_half(un >> 2, un & 3, kh, (un * 5) & 7, Q, in[I_CK], in[I_CV], XO, xch, (volatile LAS unsigned*)MISCW + 24 + pr, epoch, lane);
        }
        pool_steal(bx, G, MISCW + 26, lane, UP, in[I_SPOOL], DIFF, out + O_PP, out + O_PS);
        __syncthreads();
        for (int un = bx; un < NBAT * 4 * 16; un += G) attn_prompt_unit(un >> 6, (un >> 4) & 3, un & 15, Q, KB, VT, XO, lds, tid, wave, lane);
    }
    SEAM(5);
    if (IN(7)) {
        pg8::SchedBr S; S.Z = (const char*)DIFF; S.XO = (const char*)XO; S.GS = (const char*)GS; S.WPO = (const char*)WPGO; S.WXO = (const char*)WXO; S.WGLU = (const char*)WGLU; S.G = G; S.c = bx;
        pg8::EpiBr E; E.MG = F; E.MB = MB; E.G = GT; E.SLAB7 = SLAB7;
        pg8::gemm_phase(lds, 1024, 1024, S, E);
        TAIL_BEGIN(256 + 128)
            for (int it = tw; it < IT_GU / 2; it += ntw) { int r = it; cvt_mat<64>(r, in[I_W2U], DM, DFF, W2GU, 1, 128, scr, lane); }
        TAIL_END
    }
    SEAM(7);
    if (IN(8)) {
        for (int idx = gtid; idx < MS * 256; idx += ngt) {
            const int r = idx >> 8, c0 = (idx & 255) * 8, bt = c0 >> 7, wi = c0 & 127;
            f32x4 po[2] = {}, xa[2] = {}, va[2] = {}, ga[2] = {};
#pragma unroll
            for (int kc = 0; kc < 4; ++kc) { const float* sr = SLAB7 + ((size_t)kc * 128 + r) * 8192;
#pragma unroll
                for (int q = 0; q < 2; ++q) { po[q] += *(const f32x4*)(sr + c0 + 4 * q); xa[q] += *(const f32x4*)(sr + 2048 + c0 + 4 * q);
                    va[q] += *(const f32x4*)(sr + 4096 + bt * 256 + wi + 4 * q); ga[q] += *(const f32x4*)(sr + 4096 + bt * 256 + 128 + wi + 4 * q); } }
            const bf16_t* gr = GT + pg8::frag_off(32 * 24 + (c0 >> 8), 0, (r >> 4) & 3, (c0 >> 7) & 1, (r >> 6) & 1, (c0 >> 5) & 3, r & 15, (c0 >> 3) & 3);
            f32x4 g0a, g0b, g1a, g1b, g2a, g2b; pg8::unpack8(*(const u32x4*)gr, g0a, g0b); pg8::unpack8(*(const u32x4*)(gr + (size_t)8 * 65536), g1a, g1b); pg8::unpack8(*(const u32x4*)(gr + (size_t)16 * 65536), g2a, g2b);
            f32x4 o0, o1;
#pragma unroll
            for (int j = 0; j < 4; ++j) { o0[j] = g0a[j] * po[0][j] + g2a[j] * xa[0][j] + g1a[j] * va[0][j] * sigm(ga[0][j]); o1[j] = g0b[j] * po[1][j] + g2b[j] * xa[1][j] + g1b[j] * va[1][j] * sigm(ga[1][j]); }
            { const u32x4 w_ = pg8::pack8(o0, o1); void* p_ = MB + (size_t)(MP + r) * DM + c0;
              asm volatile("s_nop 0\n\tglobal_store_dwordx4 %0, %1, off sc1\n\ts_nop 1" :: "v"(p_), "v"(w_) : "memory"); }
        }
        asm volatile("s_waitcnt vmcnt(0)" ::: "memory");
        __syncthreads();
        if (tid == 0) (void)xb_add((unsigned*)ws + CW_P8, 1u);
        {
            pg8::SchedN2 S; S.A = (const char*)MB; S.B = (const char*)WOUT; S.nt = DM / 64; S.ta = (size_t)256 * DM * 2; S.tb = (size_t)256 * DM * 2; S.G = G; S.c = bx; S.minis = false;
            pg8::EpiF32 E; E.F = F; E.SLAB = SLAB;
            pg8::gemm_phase(lds, DM, DM, S, E);
        }
        if (bx < 8 * (DM / 256)) {
            wait_count((unsigned*)ws + CW_P8, (unsigned)G);
            pg8::SchedMini S; S.A = (const char*)MB; S.B = (const char*)WOUT; S.nt = DM / 64; S.ta = (size_t)256 * DM * 2; S.tb = (size_t)256 * DM * 2; S.c = bx;
            pg8::EpiF32 E; E.F = F; E.SLAB = SLAB;
            pg8::gemm_phase(lds, DM, DM, S, E);
        }
        TAIL_BEGIN(256 + 8 * (DM / 256))
            for (int it = IT_GU / 2 + tw; it < IT_GU; it += ntw) { int r = it; cvt_mat<64>(r, in[I_W2U], DM, DFF, W2GU, 1, 128, scr, lane); }
        TAIL_END
    }
    SEAM(9);
    if (IN(10)) { rowop_sample<1>(bx, G, wave, lane, lds, SLAB, DM / 256, nullptr, H, in[I_GMIXPOST], in[I_G2PRE], XN, nullptr);
        rowop<1>(gw, ngw, lane, F, SLAB, DM / 256, nullptr, nullptr, H, in[I_GMIXPOST], in[I_G2PRE], XN, nullptr); }
    SEAM(10);
    if (IN(11)) {
        pg8::Sched2 S; S.A0 = (const char*)XN; S.B0 = (const char*)W2GU; S.nM0 = NMT; S.nN0 = 2 * DFF / 256; S.nt0 = DM / 64; S.ta0 = (size_t)256 * DM * 2; S.tb0 = (size_t)256 * DM * 2; S.ca0 = 0;
        S.A1 = nullptr; S.B1 = nullptr; S.nM1 = 0; S.nN1 = 0; S.nt1 = 0; S.ta1 = 0; S.tb1 = 0; S.ca1 = 0; S.G = G; S.c = bx;
        pg8::EpiUp E; E.ACT = ACT; E.outK = nullptr; E.outV = nullptr; E.KB = nullptr; E.VT = nullptr;
        pg8::gemm_phase(lds, DM, DM, S, E);
        TAIL_BEGIN(NMT * (2 * DFF / 256))
            for (int it = tw; it < IT_D; it += ntw) { int r = it; cvt_mat<64>(r, in[I_W2D], DFF, DM, W2D, 0, 0, scr, lane); }
        TAIL_END
    }
    SEAM(11);
    if (IN(12)) {
        pg8::SchedN2 S; S.A = (const char*)ACT; S.B = (const char*)W2D; S.nt = DFF / 64; S.ta = (size_t)256 * DFF * 2; S.tb = (size_t)256 * DFF * 2; S.G = G; S.c = bx; S.minis = true;
        pg8::EpiF32 E; E.F = F; E.SLAB = SLAB;
        pg8::gemm_phase(lds, DFF, DFF, S, E);
    }
    SEAM(12);
    if (IN(13)) { rowop_sample<2>(bx, G, wave, lane, lds, SLAB, DFF / 256, nullptr, H, in[I_G2POST], nullptr, nullptr, out + O_Y);
        rowop<2>(gw, ngw, lane, F, SLAB, DFF / 256, nullptr, nullptr, H, in[I_G2POST], nullptr, nullptr, out + O_Y); }
#undef IN
#undef SEAM
#undef GRID_BAR
#undef TAIL_BEGIN
#undef TAIL_END
}

extern "C" void kernel_launch(void* const* d_in, const int* in_sizes, int n_in, void* d_out, int out_size, void* d_ws, size_t ws_size, hipStream_t stream) {
    static int grid = 0;
    if (grid == 0) {
        if (n_in != N_IN || ws_size < WS_END) { fprintf(stderr, "kernel_launch: expected %d inputs and >= %zu bytes of workspace; got %d, %zu\n", (int)N_IN, (size_t)WS_END, n_in, ws_size); grid = -1; return; }
        int dev = 0, cus = 0, per_cu = 0;
        (void)hipGetDevice(&dev);
        (void)hipDeviceGetAttribute(&cus, hipDeviceAttributeMultiprocessorCount, dev);
        if (hipFuncSetAttribute((const void*)mk_fwd, hipFuncAttributeMaxDynamicSharedMemorySize, LDS_BYTES) != hipSuccess) { fprintf(stderr, "kernel_launch: hipFuncSetAttribute failed\n"); grid = -1; return; }
        if (hipOccupancyMaxActiveBlocksPerMultiprocessor(&per_cu, (const void*)mk_fwd, NTHREADS, LDS_BYTES) != hipSuccess || per_cu < 1) { fprintf(stderr, "kernel_launch: occupancy query says %d\n", per_cu); per_cu = 1; }
        (void)hipGetLastError();
        grid = cus;
        if (grid > cus * per_cu) grid = cus * per_cu;
    }
    if (grid < 0) return;
    Args a{};
    for (int i = 0; i < N_IN; ++i) a.in[i] = (const float*)d_in[i];
    a.out = (float*)d_out; a.ws = (unsigned char*)d_ws;
#if MK_SINGLE
    a.ph_lo = 0; a.ph_hi = NPHASE;
    if (hipMemsetAsync(d_ws, 0, CTL_ZERO_BYTES, stream) != hipSuccess) { fprintf(stderr, "kernel_launch: hipMemsetAsync failed\n"); return; }
    hipLaunchKernelGGL(mk_fwd, dim3(grid), dim3(NTHREADS), LDS_BYTES, stream, a);
#else
    for (int p = 0; p < NPHASE; ++p) {
        a.ph_lo = p; a.ph_hi = p + 1;
        hipLaunchKernelGGL(mk_fwd, dim3(grid), dim3(NTHREADS), LDS_BYTES, stream, a);
    }
#endif
}
```

```cpp
#include <hip/hip_runtime.h>
#include <cstdio>
#include <cstdint>

#ifndef MK_SINGLE
#define MK_SINGLE 1
#endif

#define LAS __attribute__((address_space(3)))
typedef unsigned short bf16_t;
typedef short bf16x8 __attribute__((ext_vector_type(8)));
typedef short s16x4 __attribute__((ext_vector_type(4)));
typedef float f32x4 __attribute__((ext_vector_type(4)));
typedef unsigned u32x4 __attribute__((ext_vector_type(4)));
typedef unsigned u32x2 __attribute__((ext_vector_type(2)));

constexpr int DM = 2048, SEQ = 2048, NBAT = 4, MP = NBAT * SEQ, MS = 128, MT = MP + MS, MPAD = 8448, NMT = MPAD / 256;
constexpr int DFF = 5632, NMEM = 256, MEMR = NBAT * NMEM;
constexpr int PW = 1024, GW = 6144;
constexpr float RMS_EPS = 1e-6f;
constexpr int NPHASE = 14;
constexpr int NTHREADS = 512, NWAVES = 8;
constexpr int LDS_BYTES = 147456;

constexpr size_t MiB = (size_t)1 << 20;
constexpr size_t WS_W1GU = 1 * MiB, WS_W1D = 45 * MiB, WS_WIN = 67 * MiB, WS_WPG = 103 * MiB, WS_WPO = 104 * MiB, WS_WGLU = 108 * MiB, WS_WXO = 116 * MiB,
                 WS_WOUT = 120 * MiB, WS_WMKV = 128 * MiB, WS_W2GU = 136 * MiB, WS_W2D = 180 * MiB;
constexpr size_t WS_XN = 202 * MiB, WS_ACT = 235 * MiB, WS_F = 334 * MiB, WS_H = 400 * MiB, WS_UP = 466 * MiB, WS_US = 499 * MiB, WS_Q = 532 * MiB,
                 WS_DIFF = 549 * MiB, WS_Z = 566 * MiB, WS_GS = 583 * MiB, WS_XO = 600 * MiB, WS_MB = 617 * MiB, WS_MEMN = 650 * MiB, WS_KB = 654 * MiB, WS_VT = 656 * MiB,
                 WS_SLAB = 658 * MiB, WS_SLAB7 = 680 * MiB, WS_END = 696 * MiB;
constexpr size_t O_Y = 0, O_MK = 17039360, O_MV = 18087936, O_PP = 19136512, O_SRP = 19197952, O_SIP = 19214336, O_PS = 19230720, O_SRS = 21196800, O_SIS = 21721088;

enum { I_XP = 0, I_XS, I_MEM, I_CK, I_CV, I_SPOOL, I_SRE, I_SIM, I_G1PRE, I_W1G, I_W1U, I_W1D, I_G1POST, I_GMIXPRE, I_WIN, I_WPG, I_PSCALE, I_WPO,
       I_ARE, I_AIM, I_LOGSTEP, I_BRE, I_BIM, I_CRE, I_CIM, I_SSMD, I_WGV, I_WGG, I_GMEM, I_WMK, I_WMV, I_WXO, I_WOUT, I_GMIXPOST, I_G2PRE, I_W2G, I_W2U, I_W2D, I_G2POST, N_IN };

struct Args { const float* in[N_IN]; float* out; unsigned char* ws; int ph_lo, ph_hi; };

#define LDS_WAIT() asm volatile("s_waitcnt lgkmcnt(0)" ::: "memory")
__device__ __forceinline__ unsigned cvt_pk_bf16(float lo, float hi) { unsigned r; asm volatile("v_cvt_pk_bf16_f32 %0, %1, %2" : "=v"(r) : "v"(lo), "v"(hi)); return r; }
__device__ __forceinline__ float bf2f(unsigned short b) { return __uint_as_float(((unsigned)b) << 16); }
__device__ __forceinline__ float wave_sum(float v) {
#pragma unroll
    for (int o = 1; o < 64; o <<= 1) v += __shfl_xor(v, o);
    return v;
}
__device__ __forceinline__ float wave_max(float v) {
#pragma unroll
    for (int o = 1; o < 64; o <<= 1) v = fmaxf(v, __shfl_xor(v, o));
    return v;
}
__device__ __forceinline__ float sigm(float x) { return __builtin_amdgcn_rcpf(1.0f + __expf(-x)); }
__device__ __forceinline__ float gelu_tanh(float x) {
    const float z = 0.7978845608028654f * (x + 0.044715f * x * x * x);
    const float e = __expf(2.0f * z);
    const float th = 1.0f - 2.0f * __builtin_amdgcn_rcpf(e + 1.0f);
    return 0.5f * x * (1.0f + th);
}

__device__ __forceinline__ size_t us_off(size_t row, int c) {
    const int g = c >> 4, w = c & 15;
    return row < (size_t)MP ? ((((row >> 11) * 64 + g) * 2048 + (row & 2047)) * 16 + w) : ((size_t)NBAT * 64 * 2048 * 16 + ((size_t)g * 256 + (row - MP)) * 16 + w);
}
namespace pg8 {
constexpr int BM = 256, BK = 64, HALF = 128, HTB = HALF * BK * 2, STAGE_BYTES = 8 * HTB;
__device__ __forceinline__ int lds_byte(int r, int c) { const int st = (r >> 4) * 2 + (c >> 5), rr = r & 15, cc = c & 31, ob = rr * 64 + cc * 2; return st * 1024 + (ob ^ (((ob >> 9) & 1) << 5)); }
__device__ __forceinline__ void stage_rc(int b, int& R, int& C) { const int st = b / 1024, sb = b % 1024, swz = sb ^ (((sb >> 9) & 1) << 5); R = (st >> 1) * 16 + swz / 64; C = (st & 1) * 32 + (swz % 64) / 2; }
__device__ __forceinline__ int perm32(int rho) { const int n = rho >> 4, i = rho & 15; return 8 * (i >> 2) + 4 * n + (i & 3); }

struct Unit { const char* A; const char* B; int nt, pm, pn, kind, aux; };

__device__ __forceinline__ void tile_of(int L, int nM, int nN, int& pm, int& pn) {
    const int nwg = nM * nN; int wgid = L;
    { const int q = nwg / 8, r = nwg % 8, xcd = wgid % 8, off = wgid / 8; wgid = (xcd < r ? xcd * (q + 1) : r * (q + 1) + (xcd - r) * q) + off; }
    const int nig = 8 * nN, gid = wgid / nig, fm = gid * 8, gsz = (nM - fm) < 8 ? (nM - fm) : 8;
    pm = fm + ((wgid % nig) % gsz); pn = (wgid % nig) / gsz;
}

template <class Epi, class Sched>
__device__ __forceinline__ void gemm_phase(LAS unsigned char* lds, const int lda, const int ldb, const Sched& S, const Epi& E) {
    const int tid = threadIdx.x, wid = __builtin_amdgcn_readfirstlane(tid >> 6), lane = tid & 63, wr = wid >> 2, wc = wid & 3, fr = lane & 15, fq = lane >> 4;
    unsigned voffA[2], voffB[2];
#pragma unroll
    for (int i = 0; i < 2; ++i) { int R, C; stage_rc(tid * 16 + i * 8192, R, C); const int Rb = (R & ~31) + perm32(R & 31);
        voffA[i] = (unsigned)(R * lda + C) * 2u; voffB[i] = (unsigned)(Rb * ldb + C) * 2u; }
    const size_t kstep = (size_t)(BK * 2);
    const size_t hstepA = (size_t)HALF * lda * 2, hstepB = (size_t)HALF * ldb * 2;
    const unsigned ldsw = (unsigned)wid * 1024u;
    const int aoff = lds_byte(wr * 64 + fr, fq * 8), boff = lds_byte(wc * 32 + fr, fq * 8);
#define PG8_SA(b, h) (((b) * 2 + (h)) * HTB)
#define PG8_SB(b, h) ((4 + (b) * 2 + (h)) * HTB)
#define PG8_STAGE(bufoff, gbase, voff) do { _Pragma("unroll") for (int _i = 0; _i < 2; ++_i) \
        __builtin_amdgcn_global_load_lds((const unsigned*)((const char*)(gbase) + (voff)[_i]), (LAS unsigned*)(lds + (bufoff) + ldsw + _i * 8192), 16, 0, 0); } while (0)
#define PG8_LDA(dst, b, h) do { _Pragma("unroll") for (int m = 0; m < 4; ++m) _Pragma("unroll") for (int k = 0; k < 2; ++k) dst[m][k] = *(const LAS bf16x8*)(lds + PG8_SA(b, h) + aoff + m * 2048 + k * 1024); } while (0)
#define PG8_LDB(dst, b, h) do { _Pragma("unroll") for (int n = 0; n < 2; ++n) _Pragma("unroll") for (int k = 0; k < 2; ++k) dst[n][k] = *(const LAS bf16x8*)(lds + PG8_SB(b, h) + boff + n * 2048 + k * 1024); } while (0)
#define PG8_MMA(ai, bj, At, Bt) do { __builtin_amdgcn_s_setprio(1); _Pragma("unroll") for (int m = 0; m < 4; ++m) _Pragma("unroll") for (int n = 0; n < 2; ++n) _Pragma("unroll") for (int k = 0; k < 2; ++k) \
        acc[ai][bj][m][n] = __builtin_amdgcn_mfma_f32_16x16x32_bf16(Bt[n][k], At[m][k], acc[ai][bj][m][n], 0, 0, 0); __builtin_amdgcn_s_setprio(0); } while (0)
#define PG8_WAIT_V(n) asm volatile("s_waitcnt vmcnt(" #n ")" ::: "memory")
#define PG8_WAIT_L(n) asm volatile("s_waitcnt lgkmcnt(" #n ")" ::: "memory")
#define PG8_BAR __builtin_amdgcn_s_barrier()
#define PG8_SCHED __builtin_amdgcn_sched_barrier(0)
    Unit cur, nxt; int ui = 0;
    if (!S.next(0, cur)) return;
    f32x4 acc[2][2][4][2];
#pragma unroll
    for (int a = 0; a < 2; ++a)
#pragma unroll
        for (int b = 0; b < 2; ++b)
#pragma unroll
            for (int m = 0; m < 4; ++m)
#pragma unroll
                for (int n = 0; n < 2; ++n) acc[a][b][m][n] = (f32x4){0.f, 0.f, 0.f, 0.f};
    bf16x8 At[4][2], B0[2][2], B1[2][2];
    const char* cA = cur.A; const char* cB = cur.B;
    PG8_STAGE(PG8_SB(0, 0), cB, voffB); PG8_STAGE(PG8_SB(0, 1), cB + hstepB, voffB); PG8_STAGE(PG8_SA(0, 0), cA, voffA); PG8_STAGE(PG8_SA(0, 1), cA + hstepA, voffA);
    if (wr == 1) PG8_BAR;
    PG8_WAIT_V(2); PG8_BAR;
    PG8_STAGE(PG8_SB(1, 0), cB + kstep, voffB); PG8_STAGE(PG8_SA(1, 0), cA + kstep, voffA); PG8_STAGE(PG8_SB(1, 1), cB + hstepB + kstep, voffB);
    PG8_WAIT_V(6); PG8_BAR;
    for (;;) {
        const bool has_next = S.next(ui + 1, nxt);
        const char* nA = has_next ? nxt.A : cA; const char* nB = has_next ? nxt.B : cB;
        const int nt = cur.nt;
        for (int t = 0; t < nt; t += 2) {
            const bool last = (t == nt - 2);
            const char* a1 = cA + (size_t)(t + 1) * kstep;
            const char* a2 = last ? nA : cA + (size_t)(t + 2) * kstep; const char* b2 = last ? nB : cB + (size_t)(t + 2) * kstep;
            const char* a3 = a2 + kstep; const char* b3 = b2 + kstep;
            PG8_LDB(B0, 0, 0); PG8_LDB(B1, 0, 1); PG8_SCHED; PG8_LDA(At, 0, 0); PG8_STAGE(PG8_SA(1, 1), a1 + hstepA, voffA);
            PG8_WAIT_V(8); PG8_WAIT_L(0); PG8_BAR; PG8_MMA(0, 0, At, B0); PG8_MMA(0, 1, At, B1); PG8_BAR; PG8_SCHED;
            PG8_LDA(At, 0, 1); PG8_STAGE(PG8_SB(0, 0), b2, voffB); PG8_STAGE(PG8_SB(0, 1), b2 + hstepB, voffB); PG8_STAGE(PG8_SA(0, 0), a2, voffA);
            PG8_WAIT_V(8); PG8_WAIT_L(0); PG8_BAR; PG8_MMA(1, 0, At, B0); PG8_MMA(1, 1, At, B1); PG8_BAR; PG8_SCHED;
            PG8_LDB(B0, 1, 0); PG8_LDB(B1, 1, 1); PG8_SCHED; PG8_LDA(At, 1, 0); PG8_STAGE(PG8_SA(0, 1), a2 + hstepA, voffA);
            PG8_WAIT_V(8); PG8_WAIT_L(0); PG8_BAR; PG8_MMA(0, 0, At, B0); PG8_MMA(0, 1, At, B1); PG8_BAR; PG8_SCHED;
            PG8_LDA(At, 1, 1); PG8_STAGE(PG8_SB(1, 0), b3, voffB); PG8_STAGE(PG8_SB(1, 1), b3 + hstepB, voffB); PG8_STAGE(PG8_SA(1, 0), a3, voffA);
            PG8_WAIT_V(8); PG8_WAIT_L(0); PG8_BAR; PG8_MMA(1, 0, At, B0); PG8_MMA(1, 1, At, B1); PG8_BAR; PG8_SCHED;
        }
        if (wr == 0) PG8_BAR;
        E(acc, cur, wr, wc, fr, fq);
        if (!has_next) break;
#pragma unroll
        for (int a = 0; a < 2; ++a)
#pragma unroll
            for (int b = 0; b < 2; ++b)
#pragma unroll
                for (int m = 0; m < 4; ++m)
#pragma unroll
                    for (int n = 0; n < 2; ++n) acc[a][b][m][n] = (f32x4){0.f, 0.f, 0.f, 0.f};
        cur = nxt; cA = nA; cB = nB; ++ui;
        if (wr == 1) PG8_BAR;
    }
    PG8_WAIT_V(0);
    PG8_BAR;
#undef PG8_SA
#undef PG8_SB
#undef PG8_STAGE
#undef PG8_LDA
#undef PG8_LDB
#undef PG8_MMA
#undef PG8_WAIT_V
#undef PG8_WAIT_L
#undef PG8_BAR
#undef PG8_SCHED
}

struct Sched2 {
    const char *A0, *B0; int nM0, nN0, nt0; size_t ta0, tb0, ca0;
    const char *A1, *B1; int nM1, nN1, nt1; size_t ta1, tb1, ca1;
    int G, c;
    __device__ __forceinline__ bool next(int i, Unit& u) const {
        int L = i * G + c; const int n0 = nM0 * nN0, n1 = nM1 * nN1;
        if (L < n0) { int pm, pn; tile_of(L, nM0, nN0, pm, pn); u.A = A0 + (size_t)pm * ta0 + (size_t)pn * ca0; u.B = B0 + (size_t)pn * tb0; u.nt = nt0; u.pm = pm; u.pn = pn; u.kind = 0; u.aux = 0; return true; }
        L -= n0;
        if (L < n1) { int pm, pn; tile_of(L, nM1, nN1, pm, pn); u.A = A1 + (size_t)pm * ta1 + (size_t)pn * ca1; u.B = B1 + (size_t)pn * tb1; u.nt = nt1; u.pm = pm; u.pn = pn; u.kind = 1; u.aux = 0; return true; }
        return false;
    }
};
struct SchedN2 {
    const char *A, *B; int nt; size_t ta, tb; int G, c; bool minis;
    __device__ __forceinline__ bool next(int i, Unit& u) const {
        const int np = c < 256 ? (256 - c + G - 1) / G : 0;
        if (i < np) { int pm, pn; tile_of(i * G + c, 32, 8, pm, pn); u.A = A + (size_t)pm * ta; u.B = B + (size_t)pn * tb; u.nt = nt; u.pm = pm; u.pn = pn; u.kind = 0; u.aux = 0; return true; }
        if (!minis) return false;
        const int j = (i - np) * G + c;
        if (j >= 8 * (nt >> 2)) return false;
        const int pn = j & 7, kc = j >> 3;
        u.A = A + (size_t)32 * ta + (size_t)kc * 512; u.B = B + (size_t)pn * tb + (size_t)kc * 512; u.nt = 4; u.pm = 32; u.pn = pn; u.kind = 1; u.aux = kc; return true;
    }
};
struct SchedMini {
    const char *A, *B; int nt; size_t ta, tb; int c;
    __device__ __forceinline__ bool next(int i, Unit& u) const {
        if (i != 0 || c >= 8 * (nt >> 2)) return false;
        const int pn = c & 7, kc = c >> 3;
        u.A = A + (size_t)32 * ta + (size_t)kc * 512; u.B = B + (size_t)pn * tb + (size_t)kc * 512; u.nt = 4; u.pm = 32; u.pn = pn; u.kind = 1; u.aux = kc; return true;
    }
};
struct SchedBr {
    const char *Z, *XO, *GS, *WPO, *WXO, *WGLU; int G, c;
    __device__ __forceinline__ bool next(int i, Unit& u) const {
        const int ns = c < 256 ? (256 - c + G - 1) / G : 0;
        const size_t brow = (size_t)256 * 1024 * 2;
        const bool mini_first = (G == 256) && (c < 128);
        if (mini_first) { if (i == 0) i = 4 * ns; else if (i > 4 * ns) return false; else i -= 1; }
        if (i < 4 * ns) {
            const int s = i >> 2, sub = i & 3; int pm, pn; tile_of(s * G + c, 32, 8, pm, pn);
            const size_t arow = (size_t)pm * 256 * 1024 * 2;
            if (sub == 0) { u.A = Z + arow; u.B = WPO + (size_t)pn * brow; }
            else if (sub == 1) { u.A = XO + arow; u.B = WXO + (size_t)pn * brow; }
            else { u.A = GS + arow; u.B = WGLU + (size_t)(2 * pn + (sub - 2)) * brow; }
            u.nt = 16; u.pm = pm; u.pn = pn; u.kind = sub; u.aux = 0; return true;
        }
        const int j = (i - 4 * ns) * G + c;
        if (j >= 128) return false;
        const int tt = j & 31, kc = j >> 5; const size_t arow = (size_t)32 * 256 * 1024 * 2 + (size_t)kc * 512;
        if (tt < 8) { u.A = Z + arow; u.B = WPO + (size_t)tt * brow + (size_t)kc * 512; }
        else if (tt < 16) { u.A = XO + arow; u.B = WXO + (size_t)(tt - 8) * brow + (size_t)kc * 512; }
        else { u.A = GS + arow; u.B = WGLU + (size_t)(tt - 16) * brow + (size_t)kc * 512; }
        u.nt = 4; u.pm = 32; u.pn = tt; u.kind = 4; u.aux = kc; return true;
    }
};

#define EPI_ARGS const f32x4 (&acc)[2][2][4][2], const Unit& u, int wr, int wc, int fr, int fq
__device__ __forceinline__ u32x4 pack8(const f32x4& a, const f32x4& b) { u32x4 w; w.x = cvt_pk_bf16(a[0], a[1]); w.y = cvt_pk_bf16(a[2], a[3]); w.z = cvt_pk_bf16(b[0], b[1]); w.w = cvt_pk_bf16(b[2], b[3]); return w; }

__device__ __forceinline__ size_t frag_off(int tile, int ai, int m, int bj, int wr, int wc, int fr, int fq) {
    return ((size_t)tile * 16 + (size_t)((ai * 4 + m) * 2 + bj)) * 4096 + (size_t)(((wr * 4 + wc) * 64 + fq * 16 + fr) * 8);
}
struct EpiUp {
    bf16_t* ACT; float* outK; float* outV; bf16_t* KB; bf16_t* VT;
    __device__ __forceinline__ void operator()(EPI_ARGS) const {
        if (u.kind == 0) {
            const int row0 = u.pm * 256 + wr * 64 + fr, a0 = u.pn * 128 + wc * 32 + 8 * fq;
#pragma unroll
            for (int ai = 0; ai < 2; ++ai)
#pragma unroll
                for (int m = 0; m < 4; ++m) {
                    f32x4 v0, v1;
#pragma unroll
                    for (int j = 0; j < 4; ++j) { const float g0 = acc[ai][0][m][0][j], g1 = acc[ai][0][m][1][j];
                        v0[j] = g0 * sigm(g0) * acc[ai][1][m][0][j]; v1[j] = g1 * sigm(g1) * acc[ai][1][m][1][j]; }
                    *(u32x4*)(ACT + (size_t)(row0 + ai * 128 + m * 16) * DFF + a0) = pack8(v0, v1);
                }
        } else {
            const int row0 = u.pm * 256 + wr * 64 + fr;
#pragma unroll
            for (int ai = 0; ai < 2; ++ai)
#pragma unroll
                for (int m = 0; m < 4; ++m) {
                    const int r = row0 + ai * 128 + m * 16;
#pragma unroll
                    for (int bj = 0; bj < 2; ++bj) {
                        const int c0 = u.pn * 256 + bj * 128 + wc * 32 + 8 * fq;
                        const f32x4 v0 = acc[ai][bj][m][0], v1 = acc[ai][bj][m][1];
                        if (u.pn < 4) {
                            float* o = outK + (size_t)r * 1024 + c0; *(f32x4*)o = v0; *(f32x4*)(o + 4) = v1;
                            *(u32x4*)(KB + (size_t)r * 1024 + c0) = pack8(v0, v1);
                        } else {
                            const int cc = c0 - 1024;
                            float* o = outV + (size_t)r * 1024 + cc; *(f32x4*)o = v0; *(f32x4*)(o + 4) = v1;
                            const u32x4 w = pack8(v0, v1);
                            bf16_t* vt = VT + ((size_t)((r >> 8) * 4 + (cc >> 8)) * 256 + (cc & 255)) * 256 + (r & 255);
                            vt[0 * 256] = (bf16_t)(w.x & 0xffff); vt[1 * 256] = (bf16_t)(w.x >> 16); vt[2 * 256] = (bf16_t)(w.y & 0xffff); vt[3 * 256] = (bf16_t)(w.y >> 16);
                            vt[4 * 256] = (bf16_t)(w.z & 0xffff); vt[5 * 256] = (bf16_t)(w.z >> 16); vt[6 * 256] = (bf16_t)(w.w & 0xffff); vt[7 * 256] = (bf16_t)(w.w >> 16);
                        }
                    }
                }
        }
    }
};
struct EpiF32 {
    float* F; float* SLAB;
    __device__ __forceinline__ void operator()(EPI_ARGS) const {
        if (u.kind == 0) {
            const int row0 = u.pm * 256 + wr * 64 + fr;
#pragma unroll
            for (int ai = 0; ai < 2; ++ai)
#pragma unroll
                for (int m = 0; m < 4; ++m) {
                    bf16_t* rp = (bf16_t*)F + (size_t)(row0 + ai * 128 + m * 16) * DM + u.pn * 256 + wc * 32 + 8 * fq;
#pragma unroll
                    for (int bj = 0; bj < 2; ++bj) *(u32x4*)(rp + bj * 128) = pack8(acc[ai][bj][m][0], acc[ai][bj][m][1]);
                }
        } else {
#pragma unroll
            for (int m = 0; m < 4; ++m) {
                float* rp = SLAB + ((size_t)u.aux * 128 + wr * 64 + m * 16 + fr) * DM + u.pn * 256 + wc * 32 + 8 * fq;
#pragma unroll
                for (int bj = 0; bj < 2; ++bj) { *(f32x4*)(rp + bj * 128) = acc[0][bj][m][0]; *(f32x4*)(rp + bj * 128 + 4) = acc[0][bj][m][1]; }
            }
        }
    }
};
struct EpiIn {
    float* UP; float* US; bf16_t* Q; bf16_t* G; bf16_t* WPGO;
    __device__ __forceinline__ void operator()(EPI_ARGS) const {
        const int row0 = u.pm * 256 + wr * 64 + fr, pn = u.pn;
        if (u.kind == 1) {
#pragma unroll
            for (int ai = 0; ai < 2; ++ai)
#pragma unroll
                for (int m = 0; m < 4; ++m)
#pragma unroll
                    for (int bj = 0; bj < 2; ++bj)
                        *(u32x4*)(WPGO + (size_t)(row0 + ai * 128 + m * 16) * 1024 + pn * 256 + bj * 128 + wc * 32 + 8 * fq) = pack8(acc[ai][bj][m][0], acc[ai][bj][m][1]);
            return;
        }
#pragma unroll
        for (int ai = 0; ai < 2; ++ai)
#pragma unroll
            for (int m = 0; m < 4; ++m) {
                const size_t r = (size_t)(row0 + ai * 128 + m * 16);
#pragma unroll
                for (int bj = 0; bj < 2; ++bj) {
                    const int c0 = pn * 256 + bj * 128 + wc * 32 + 8 * fq;
                    f32x4 v0 = acc[ai][bj][m][0], v1 = acc[ai][bj][m][1];
                    if (pn < 4) *(u32x4*)((bf16_t*)UP + r * 1024 + c0) = pack8(v0, v1);
                    else if (pn < 8) *(u32x4*)((bf16_t*)US + us_off(r, c0 - 1024)) = pack8(v0, v1);
                    else if (pn < 12) { v0 *= 0.0625f; v1 *= 0.0625f; *(u32x4*)(Q + r * 1024 + (c0 - 2048)) = pack8(v0, v1); }
                    else {
#pragma unroll
                        for (int j = 0; j < 4; ++j) { v0[j] = sigm(v0[j]); v1[j] = sigm(v1[j]); }
                        *(u32x4*)(G + frag_off(u.pm * 24 + (pn - 12), ai, m, bj, wr, wc, fr, fq)) = pack8(v0, v1);
                    }
                }
            }
    }
};
__device__ __forceinline__ void unpack8(const u32x4& w, f32x4& a, f32x4& b) {
    a[0] = __uint_as_float(w.x << 16); a[1] = __uint_as_float(w.x & 0xffff0000u); a[2] = __uint_as_float(w.y << 16); a[3] = __uint_as_float(w.y & 0xffff0000u);
    b[0] = __uint_as_float(w.z << 16); b[1] = __uint_as_float(w.z & 0xffff0000u); b[2] = __uint_as_float(w.w << 16); b[3] = __uint_as_float(w.w & 0xffff0000u);
}
struct EpiBr {
    float* MG; bf16_t* MB; const bf16_t* G; float* SLAB7;
    __device__ __forceinline__ void operator()(EPI_ARGS) const {
        const int row0 = u.pm * 256 + wr * 64 + fr, kind = u.kind;
        if (kind == 4) {
#pragma unroll
            for (int m = 0; m < 4; ++m) {
                float* rp = SLAB7 + ((size_t)u.aux * 128 + wr * 64 + m * 16 + fr) * 8192 + u.pn * 256 + wc * 32 + 8 * fq;
#pragma unroll
                for (int bj = 0; bj < 2; ++bj) { *(f32x4*)(rp + bj * 128) = acc[0][bj][m][0]; *(f32x4*)(rp + bj * 128 + 4) = acc[0][bj][m][1]; }
            }
            return;
        }
        if (kind >= 2) {
            u32x4 gq[2][4], oq[2][4];
#pragma unroll
            for (int ai = 0; ai < 2; ++ai)
#pragma unroll
                for (int m = 0; m < 4; ++m) { gq[ai][m] = *(const u32x4*)(G + frag_off(u.pm * 24 + 8 + u.pn, ai, m, kind - 2, wr, wc, fr, fq)); oq[ai][m] = *(const u32x4*)((const bf16_t*)MG + frag_off(u.pm * 8 + u.pn, ai, m, kind - 2, wr, wc, fr, fq)); }
            __builtin_amdgcn_sched_barrier(0);
#pragma unroll
            for (int ai = 0; ai < 2; ++ai)
#pragma unroll
                for (int m = 0; m < 4; ++m) { const size_t r = (size_t)(row0 + ai * 128 + m * 16); const int c0 = u.pn * 256 + (kind - 2) * 128 + wc * 32 + 8 * fq;
                    f32x4 g0, g1; unpack8(gq[ai][m], g0, g1);
                    f32x4 v0, v1; unpack8(oq[ai][m], v0, v1);
#pragma unroll
                    for (int j = 0; j < 4; ++j) { v0[j] += g0[j] * acc[ai][0][m][0][j] * sigm(acc[ai][1][m][0][j]); v1[j] += g1[j] * acc[ai][0][m][1][j] * sigm(acc[ai][1][m][1][j]); }
                    *(u32x4*)(MB + r * DM + c0) = pack8(v0, v1); }
            return;
        }
#pragma unroll
        for (int ai = 0; ai < 2; ++ai) {
            u32x4 gq[4][2], pq[4][2];
#pragma unroll
            for (int m = 0; m < 4; ++m)
#pragma unroll
                for (int bj = 0; bj < 2; ++bj) {
                    gq[m][bj] = *(const u32x4*)(G + frag_off(u.pm * 24 + (kind == 0 ? 0 : 16) + u.pn, ai, m, bj, wr, wc, fr, fq));
                    if (kind == 1) pq[m][bj] = *(const u32x4*)((const bf16_t*)MG + frag_off(u.pm * 8 + u.pn, ai, m, bj, wr, wc, fr, fq)); }
            __builtin_amdgcn_sched_barrier(0);
#pragma unroll
            for (int m = 0; m < 4; ++m)
#pragma unroll
                for (int bj = 0; bj < 2; ++bj) {
                    f32x4 g0, g1; unpack8(gq[m][bj], g0, g1);
                    f32x4 v0 = g0 * acc[ai][bj][m][0], v1 = g1 * acc[ai][bj][m][1];
                    if (kind == 1) { f32x4 p0, p1; unpack8(pq[m][bj], p0, p1); v0 += p0; v1 += p1; }
                    *(u32x4*)((bf16_t*)MG + frag_off(u.pm * 8 + u.pn, ai, m, bj, wr, wc, fr, fq)) = pack8(v0, v1); }
        }
    }
};
}

template <int DEPTH>
__device__ __forceinline__ void cvt_item(const float* __restrict__ W, int N, bf16_t* D, int ldk, int k0, int n0, int drow0, LAS float* scr, int lane) {
    const float* src = W + (size_t)k0 * N + n0 + lane;
#pragma unroll
    for (int i0 = 0; i0 < 64; i0 += DEPTH) {
        float v[DEPTH];
#pragma unroll
        for (int d = 0; d < DEPTH; ++d) v[d] = __builtin_nontemporal_load(src + (size_t)(i0 + d) * N);
        __builtin_amdgcn_sched_barrier(0);
#pragma unroll
        for (int d = 0; d < DEPTH; ++d) scr[(i0 + d) * 65 + lane] = v[d];
    }
    LDS_WAIT();
    const int c = lane & 7;
#pragma unroll
    for (int j = 0; j < 8; ++j) { const int n = (lane >> 3) + 8 * j; const LAS float* s = scr + (8 * c) * 65 + n;
        u32x4 o; o.x = cvt_pk_bf16(s[0 * 65], s[1 * 65]); o.y = cvt_pk_bf16(s[2 * 65], s[3 * 65]); o.z = cvt_pk_bf16(s[4 * 65], s[5 * 65]); o.w = cvt_pk_bf16(s[6 * 65], s[7 * 65]);
        *(u32x4*)(D + (size_t)(drow0 + n) * ldk + k0 + 8 * c) = o; }
    LDS_WAIT();
}
template <int DEPTH = 16>
__device__ __forceinline__ bool cvt_mat(int& r, const float* W, int K, int N, bf16_t* D, int mode, int roff, LAS float* scr, int lane, int ldk = 0) {
    const int nb = N / 64, items = (K / 64) * nb;
    if (r >= items) { r -= items; return false; }
    const int nkb = K / 64; const int kb = r % nkb, n0 = (r / nkb) * 64;
    const int drow0 = mode ? ((n0 >> 7) * 256 + roff + (n0 & 127)) : (roff + n0);
    cvt_item<DEPTH>(W, N, D, ldk ? ldk : K, kb * 64, n0, drow0, scr, lane);
    return true;
}
__device__ __forceinline__ void rms_row_bf16(const float* xrow, const float* g, bf16_t* orow, int lane) {
    f32x4 v[8]; float s = 0.f;
#pragma unroll
    for (int j = 0; j < 8; ++j) { v[j] = *(const f32x4*)(xrow + 4 * lane + 256 * j); s += (v[j][0] * v[j][0] + v[j][1] * v[j][1]) + (v[j][2] * v[j][2] + v[j][3] * v[j][3]); }
    const float r = 1.0f / sqrtf(wave_sum(s) * (1.0f / DM) + RMS_EPS);
#pragma unroll
    for (int j = 0; j < 8; ++j) { const f32x4 gv = *(const f32x4*)(g + 4 * lane + 256 * j); const f32x4 o = v[j] * r * gv;
        u32x2 w; w.x = cvt_pk_bf16(o[0], o[1]); w.y = cvt_pk_bf16(o[2], o[3]); *(u32x2*)(orow + 4 * lane + 256 * j) = w; }
}
__device__ __forceinline__ const float* xrow_ptr(const float* xp, const float* xs, int m) { return m < MP ? xp + (size_t)m * DM : xs + (size_t)(m - MP) * DM; }

template <int MODE>
__device__ __forceinline__ void rowop(int gw, int ngw, int lane, const float* F, const float* SLAB, int nslab, const float* xp, const float* xs, float* H, const float* gpost, const float* gpre, bf16_t* XN, float* out) {
    for (int m = gw; m < MP; m += ngw) {
        const bf16_t* frow = (const bf16_t*)F + (size_t)m * DM; const float* brow = (MODE == 0) ? xrow_ptr(xp, xs, m) : nullptr; const bf16_t* hrow = (const bf16_t*)H + (size_t)m * DM;
        f32x4 f[8]; float s = 0.f;
        if (m < MP) {
#pragma unroll
            for (int j = 0; j < 8; ++j) { const u32x2 w = __builtin_nontemporal_load((const u32x2*)(frow + 4 * lane + 256 * j));
                f[j][0] = __uint_as_float(w.x << 16); f[j][1] = __uint_as_float(w.x & 0xffff0000u); f[j][2] = __uint_as_float(w.y << 16); f[j][3] = __uint_as_float(w.y & 0xffff0000u); }
        } else {
#pragma unroll
            for (int j = 0; j < 8; ++j) f[j] = (f32x4){0.f, 0.f, 0.f, 0.f};
            for (int k = 0; k < nslab; ++k) { const float* srow = SLAB + ((size_t)k * 128 + (m - MP)) * DM;
#pragma unroll
                for (int j = 0; j < 8; ++j) f[j] += *(const f32x4*)(srow + 4 * lane + 256 * j); }
        }
#pragma unroll
        for (int j = 0; j < 8; ++j) s += (f[j][0] * f[j][0] + f[j][1] * f[j][1]) + (f[j][2] * f[j][2] + f[j][3] * f[j][3]);
        const float r = ((MODE == 1) ? 1.0f : 0.5f) / sqrtf(wave_sum(s) * (1.0f / DM) + RMS_EPS);
        float s2 = 0.f;
#pragma unroll
        for (int j = 0; j < 8; ++j) { const f32x4 gv = *(const f32x4*)(gpost + 4 * lane + 256 * j); f32x4 bv; if (MODE == 0) bv = __builtin_nontemporal_load((const f32x4*)(brow + 4 * lane + 256 * j)); else { const u32x2 hw = __builtin_nontemporal_load((const u32x2*)(hrow + 4 * lane + 256 * j)); bv[0] = __uint_as_float(hw.x << 16); bv[1] = __uint_as_float(hw.x & 0xffff0000u); bv[2] = __uint_as_float(hw.y << 16); bv[3] = __uint_as_float(hw.y & 0xffff0000u); }
            f[j] = bv + f[j] * r * gv; s2 += (f[j][0] * f[j][0] + f[j][1] * f[j][1]) + (f[j][2] * f[j][2] + f[j][3] * f[j][3]); }
        if (MODE == 2) {
#pragma unroll
            for (int j = 0; j < 8; ++j) __builtin_nontemporal_store(f[j], (f32x4*)(out + (size_t)m * DM + 4 * lane + 256 * j));
        } else {
            const float r2 = 1.0f / sqrtf(wave_sum(s2) * (1.0f / DM) + RMS_EPS);
#pragma unroll
            for (int j = 0; j < 8; ++j) { { u32x2 hw; hw.x = cvt_pk_bf16(f[j][0], f[j][1]); hw.y = cvt_pk_bf16(f[j][2], f[j][3]); __builtin_nontemporal_store(hw, (u32x2*)((bf16_t*)H + (size_t)m * DM + 4 * lane + 256 * j)); }
                const f32x4 gv = *(const f32x4*)(gpre + 4 * lane + 256 * j); const f32x4 o = f[j] * r2 * gv;
                u32x2 w; w.x = cvt_pk_bf16(o[0], o[1]); w.y = cvt_pk_bf16(o[2], o[3]); *(u32x2*)(XN + (size_t)m * DM + 4 * lane + 256 * j) = w; }
        }
    }
}

__device__ __forceinline__ f32x4 bf4(const u32x2& w) { f32x4 r; r[0] = __uint_as_float(w.x << 16); r[1] = __uint_as_float(w.x & 0xffff0000u); r[2] = __uint_as_float(w.y << 16); r[3] = __uint_as_float(w.y & 0xffff0000u); return r; }
__device__ __forceinline__ f32x4 ld4bf(const bf16_t* p) { const u32x2 w = *(const u32x2*)p; f32x4 r; r[0] = __uint_as_float(w.x << 16); r[1] = __uint_as_float(w.x & 0xffff0000u); r[2] = __uint_as_float(w.y << 16); r[3] = __uint_as_float(w.y & 0xffff0000u); return r; }
template <int MODE>
__device__ __forceinline__ void rowop_sample(int bx, int G, int wave, int lane, LAS unsigned char* lds, const float* SLAB, int nslab, const float* xs, float* H, const float* gpost, const float* gpre, bf16_t* XN, float* out) {
    LAS float* red = (LAS float*)lds;
    for (int r = bx; r < MS; r += G) {
        const int m = MP + r, c = wave * 256 + 4 * lane;
        f32x4 f = (f32x4){0.f, 0.f, 0.f, 0.f};
        for (int k = 0; k < nslab; ++k) f += *(const f32x4*)(SLAB + ((size_t)k * 128 + r) * DM + c);
        float s = wave_sum((f[0] * f[0] + f[1] * f[1]) + (f[2] * f[2] + f[3] * f[3]));
        if (lane == 0) red[wave] = s;
        __syncthreads();
        s = ((red[0] + red[1]) + (red[2] + red[3])) + ((red[4] + red[5]) + (red[6] + red[7]));
        const float rr = ((MODE == 1) ? 1.0f : 0.5f) / sqrtf(s * (1.0f / DM) + RMS_EPS);
        f32x4 bv;
        if (MODE == 0) bv = *(const f32x4*)(xs + (size_t)r * DM + c);
        else { const u32x2 hw = *(const u32x2*)((const bf16_t*)H + (size_t)m * DM + c); bv[0] = __uint_as_float(hw.x << 16); bv[1] = __uint_as_float(hw.x & 0xffff0000u); bv[2] = __uint_as_float(hw.y << 16); bv[3] = __uint_as_float(hw.y & 0xffff0000u); }
        const f32x4 gv = *(const f32x4*)(gpost + c);
        f = bv + f * rr * gv;
        if (MODE == 2) { *(f32x4*)(out + (size_t)m * DM + c) = f; }
        else {
            float s2 = wave_sum((f[0] * f[0] + f[1] * f[1]) + (f[2] * f[2] + f[3] * f[3]));
            if (lane == 0) red[8 + wave] = s2;
            __syncthreads();
            s2 = ((red[8] + red[9]) + (red[10] + red[11])) + ((red[12] + red[13]) + (red[14] + red[15]));
            const float r2 = 1.0f / sqrtf(s2 * (1.0f / DM) + RMS_EPS);
            { u32x2 hw; hw.x = cvt_pk_bf16(f[0], f[1]); hw.y = cvt_pk_bf16(f[2], f[3]); *(u32x2*)((bf16_t*)H + (size_t)m * DM + c) = hw; }
            const f32x4 gp = *(const f32x4*)(gpre + c); const f32x4 o = f * r2 * gp;
            u32x2 w; w.x = cvt_pk_bf16(o[0], o[1]); w.y = cvt_pk_bf16(o[2], o[3]); *(u32x2*)(XN + (size_t)m * DM + c) = w;
        }
        __syncthreads();
    }
}

constexpr int POOL_NCHUNK = 2048 + 512 + 240 + 960;
template <int W>
__device__ __forceinline__ void pool_item(const bf16_t* __restrict__ UP, bf16_t* __restrict__ DIFF, int m0, int t0, int c) {
    const bf16_t* base = UP + (size_t)m0 * PW + c;
    const bool first = (t0 == 0);
    u32x2 r[W + 15];
#pragma unroll
    for (int k = 0; k < W + 15; ++k) { const int dt = k - (W - 1); const bf16_t* a = (dt < 0 && first) ? base : base + (long)dt * PW; r[k] = *(const u32x2*)a; }
    __builtin_amdgcn_sched_barrier(0);
    if (first) {
#pragma unroll
        for (int k = 0; k < W - 1; ++k) r[k] = (u32x2){0u, 0u};
    }
    f32x4 sum = (f32x4){0.f, 0.f, 0.f, 0.f};
#pragma unroll
    for (int s = 1; s < W; ++s) sum += bf4(r[W - 1 - s]);
#pragma unroll
    for (int i = 0; i < 16; ++i) {
        const f32x4 uv = bf4(r[W - 1 + i]);
        sum += uv;
        const int t = t0 + i, cnt = (t + 1) < W ? (t + 1) : W;
        const f32x4 d = sum / (float)cnt - uv;
        u32x2 o; o.x = cvt_pk_bf16(d[0], d[1]); o.y = cvt_pk_bf16(d[2], d[3]); *(u32x2*)(DIFF + (size_t)(m0 + i) * PW + c) = o;
        sum -= bf4(r[i]);
    }
}
__device__ __forceinline__ void pool_chunk(int q, int lane, const float* UPf, const float* spool, bf16_t* DIFF, float* out_pp, float* out_ps) {
    const bf16_t* UP = (const bf16_t*)UPf;
    if (q < 2048) {
        const int idx = q * 64 + lane;
        const int c = (idx & 255) * 4, ch = idx >> 8, m0 = ch * 16, t0 = m0 & (SEQ - 1), grp = q & 3;
        if (grp == 0) pool_item<2>(UP, DIFF, m0, t0, c);
        else if (grp == 1) pool_item<4>(UP, DIFF, m0, t0, c);
        else if (grp == 2) pool_item<8>(UP, DIFF, m0, t0, c);
        else pool_item<16>(UP, DIFF, m0, t0, c);
    } else if (q < 2560) {
        const int idx = (q - 2048) * 64 + lane;
        const int c = (idx & 255) * 4, b = idx >> 8, w = 2 << (c >> 8);
        const f32x4 uv = ld4bf(UP + (size_t)(MP + b) * PW + c);
        f32x4 sum = uv;
        for (int e = 16 - w; e < 15; ++e) sum += *(const f32x4*)(spool + ((size_t)b * 15 + e) * PW + c);
        const f32x4 d = sum / (float)w - uv;
        u32x2 o; o.x = cvt_pk_bf16(d[0], d[1]); o.y = cvt_pk_bf16(d[2], d[3]); *(u32x2*)(DIFF + (size_t)(MP + b) * PW + c) = o;
    } else if (q < 2800) {
        const int idx = (q - 2560) * 64 + lane; const int c = (idx & 255) * 4, e = (idx >> 8) % 15, b = (idx >> 8) / 15;
        *(f32x4*)(out_pp + ((size_t)b * 15 + e) * PW + c) = ld4bf(UP + ((size_t)b * SEQ + (SEQ - 15) + e) * PW + c);
    } else {
        f32x4 v[8];
#pragma unroll
        for (int j = 0; j < 8; ++j) { const int idx = ((q - 2800) * 8 + j) * 64 + lane; const int c = (idx & 255) * 4, e = (idx >> 8) % 15, b = (idx >> 8) / 15;
            v[j] = (e < 14) ? *(const f32x4*)(spool + ((size_t)b * 15 + e + 1) * PW + c) : ld4bf(UP + (size_t)(MP + b) * PW + c); }
        __builtin_amdgcn_sched_barrier(0);
#pragma unroll
        for (int j = 0; j < 8; ++j) { const int idx = ((q - 2800) * 8 + j) * 64 + lane; const int c = (idx & 255) * 4, e = (idx >> 8) % 15, b = (idx >> 8) / 15;
            *(f32x4*)(out_ps + ((size_t)b * 15 + e) * PW + c) = v[j]; }
    }
}
__device__ __forceinline__ void pool_steal(int bx, int G, LAS unsigned* counter, int lane, const float* UPf, const float* spool, bf16_t* DIFF, float* out_pp, float* out_ps) {
    for (;;) {
        unsigned n = 0;
        if (lane == 0) n = __hip_atomic_fetch_add(counter, 1u, __ATOMIC_RELAXED, __HIP_MEMORY_SCOPE_WORKGROUP);
        n = (unsigned)__builtin_amdgcn_readfirstlane((int)n);
        const int q = bx + (int)n * G;
        if (q >= POOL_NCHUNK) break;
        pool_chunk(q, lane, UPf, spool, DIFF, out_pp, out_ps);
    }
}

__device__ __forceinline__ double dexp_small(double x) {
    const double z = x * (1.0 / 256.0); double term = 1.0, e = 1.0;
#pragma unroll
    for (int k = 1; k <= 12; ++k) { term *= z / (double)k; e += term; }
#pragma unroll
    for (int k = 0; k < 8; ++k) e = e * e;
    return e;
}
__device__ __forceinline__ void ssm_params(int g, int n, const float* a_re, const float* a_im, const float* log_step, const float* b_re, const float* b_im,
                                           float& lr, float& li, float& pr, float& pi, float (&bbr)[16], float (&bbi)[16], int nsq = 8) {
    const double dt = dexp_small((double)log_step[g]);
    const double ar = (double)a_re[g * 64 + n], ai = (double)a_im[g * 64 + n];
    const double mag = dexp_small(ar * dt);
    const double ang = ai * dt; const double TWO_PI = 6.283185307179586476925;
    const double r = ang - rint(ang / TWO_PI) * TWO_PI, r2 = r * r;
    double sn = r, cs = 1.0, ts = r, tc = 1.0;
#pragma unroll
    for (int k = 1; k <= 14; ++k) { tc *= -r2 / (double)((2 * k - 1) * (2 * k)); cs += tc; ts *= -r2 / (double)((2 * k) * (2 * k + 1)); sn += ts; }
    const double lbr = mag * cs, lbi = mag * sn;
    const double den = ar * ar + ai * ai, nre = lbr - 1.0;
    const double fre = (nre * ar + lbi * ai) / den, fim = (lbi * ar - nre * ai) / den;
    lr = (float)lbr; li = (float)lbi;
    double qr = lbr, qi = lbi;
#pragma unroll
    for (int k = 0; k < nsq; ++k) { const double t = qr * qr - qi * qi; qi = 2.0 * qr * qi; qr = t; }
    pr = (float)qr; pi = (float)qi;
    const float* br = b_re + (size_t)(g * 64 + n) * 16; const float* bi = b_im + (size_t)(g * 64 + n) * 16;
#pragma unroll
    for (int h4 = 0; h4 < 4; ++h4) { const f32x4 x = *(const f32x4*)(br + 4 * h4), y = *(const f32x4*)(bi + 4 * h4);
#pragma unroll
        for (int j = 0; j < 4; ++j) { bbr[4 * h4 + j] = (float)(fre * (double)x[j] - fim * (double)y[j]); bbi[4 * h4 + j] = (float)(fre * (double)y[j] + fim * (double)x[j]); } }
}
__device__ __forceinline__ void ssm_cfrag(int g, int lane, const float* c_re, const float* c_im, bf16x8 (&cf)[4]) {
    const int h = lane & 15, q4 = lane >> 4;
#pragma unroll
    for (int ks = 0; ks < 4; ++ks) {
        const f32x4 cr = *(const f32x4*)(c_re + (size_t)(g * 16 + h) * 64 + 16 * ks + 4 * q4), ci = *(const f32x4*)(c_im + (size_t)(g * 16 + h) * 64 + 16 * ks + 4 * q4);
        u32x4 w; w.x = cvt_pk_bf16(cr[0], -ci[0]); w.y = cvt_pk_bf16(cr[1], -ci[1]); w.z = cvt_pk_bf16(cr[2], -ci[2]); w.w = cvt_pk_bf16(cr[3], -ci[3]);
        cf[ks] = __builtin_bit_cast(bf16x8, w);
    }
}
constexpr int SSM_WSTRIDE = 23040;
#define SSM_STEP(UPTR) do { const f32x4 _u0 = *(const LAS f32x4*)(UPTR), _u1 = *(const LAS f32x4*)((UPTR) + 4), _u2 = *(const LAS f32x4*)((UPTR) + 8), _u3 = *(const LAS f32x4*)((UPTR) + 12); \
        float _r0 = bbr[0] * _u0[0], _r1 = bbr[1] * _u0[1], _i0 = bbi[0] * _u0[0], _i1 = bbi[1] * _u0[1]; \
        _r0 = fmaf(bbr[2], _u0[2], _r0); _r1 = fmaf(bbr[3], _u0[3], _r1); _i0 = fmaf(bbi[2], _u0[2], _i0); _i1 = fmaf(bbi[3], _u0[3], _i1); \
        _r0 = fmaf(bbr[4], _u1[0], _r0); _r1 = fmaf(bbr[5], _u1[1], _r1); _i0 = fmaf(bbi[4], _u1[0], _i0); _i1 = fmaf(bbi[5], _u1[1], _i1); \
        _r0 = fmaf(bbr[6], _u1[2], _r0); _r1 = fmaf(bbr[7], _u1[3], _r1); _i0 = fmaf(bbi[6], _u1[2], _i0); _i1 = fmaf(bbi[7], _u1[3], _i1); \
        _r0 = fmaf(bbr[8], _u2[0], _r0); _r1 = fmaf(bbr[9], _u2[1], _r1); _i0 = fmaf(bbi[8], _u2[0], _i0); _i1 = fmaf(bbi[9], _u2[1], _i1); \
        _r0 = fmaf(bbr[10], _u2[2], _r0); _r1 = fmaf(bbr[11], _u2[3], _r1); _i0 = fmaf(bbi[10], _u2[2], _i0); _i1 = fmaf(bbi[11], _u2[3], _i1); \
        _r0 = fmaf(bbr[12], _u3[0], _r0); _r1 = fmaf(bbr[13], _u3[1], _r1); _i0 = fmaf(bbi[12], _u3[0], _i0); _i1 = fmaf(bbi[13], _u3[1], _i1); \
        _r0 = fmaf(bbr[14], _u3[2], _r0); _r1 = fmaf(bbr[15], _u3[3], _r1); _i0 = fmaf(bbi[14], _u3[2], _i0); _i1 = fmaf(bbi[15], _u3[3], _i1); \
        const float _nr = fmaf(lr, xr, fmaf(-li, xi, _r0 + _r1)), _ni = fmaf(lr, xi, fmaf(li, xr, _i0 + _i1)); xr = _nr; xi = _ni; } while (0)

constexpr int SSM_NW = 4, SSM_CH = SEQ / SSM_NW, SSM_SUBS = SSM_CH / 64;
__device__ __forceinline__ void ssm_prompt_unit(int b, int g, const float* US, bf16_t* GS, float* out_re, float* out_im, const float* const* in, LAS unsigned char* lds, volatile LAS unsigned* flags, unsigned epoch, int wave, int lane) {
    float lr, li, pr, pi;
    LAS float* ub = (LAS float*)(lds + wave * SSM_WSTRIDE);
    LAS unsigned* xt = (LAS unsigned*)(lds + wave * SSM_WSTRIDE + 8192);
    LAS float* but = (LAS float*)(lds + wave * SSM_WSTRIDE + 12544);
    volatile LAS float* sb = (volatile LAS float*)(lds + SSM_NW * SSM_WSTRIDE);
    const int l15 = lane & 15, q4 = lane >> 4;
    bf16x8 bfr[8];
    {
        float bbr[16], bbi[16];
        ssm_params(g, lane, in[I_ARE], in[I_AIM], in[I_LOGSTEP], in[I_BRE], in[I_BIM], lr, li, pr, pi, bbr, bbi, 9);
        LAS unsigned* tb = (LAS unsigned*)but;
#pragma unroll
        for (int k = 0; k < 8; ++k) { tb[lane * 8 + k] = cvt_pk_bf16(bbr[2 * k], bbr[2 * k + 1]); tb[(64 + lane) * 8 + k] = cvt_pk_bf16(bbi[2 * k], bbi[2 * k + 1]); }
        LDS_WAIT();
#pragma unroll
        for (int nb = 0; nb < 8; ++nb) { u32x4 w = (u32x4){0u, 0u, 0u, 0u}; if (q4 < 2) w = *(const LAS u32x4*)(tb + (16 * nb + l15) * 8 + 4 * q4); bfr[nb] = __builtin_bit_cast(bf16x8, w); }
        LDS_WAIT();
    }
    const size_t row0 = (size_t)b * SEQ + (size_t)wave * SSM_CH;
    const bf16_t* up = (const bf16_t*)US + us_off(row0, g * 16);
    u32x2 pk[SSM_SUBS][4];
#pragma unroll
    for (int _s = 0; _s < SSM_SUBS; ++_s)
#pragma unroll
        for (int _i = 0; _i < 4; ++_i) { const int _p = _i * 64 + lane; pk[_s][_i] = *(const u32x2*)(up + (size_t)(_s * 64 + (_p >> 2)) * 16 + (_p & 3) * 4); }
#define SSM_STOREU(buf, sub) do { _Pragma("unroll") for (int _i = 0; _i < 4; ++_i) *(LAS f32x4*)(ub + (buf) * 1024 + (_i * 64 + lane) * 4) = bf4(pk[sub][_i]); } while (0)
#define SSM_TILE_BU(UT) \
        f32x4 bre[4], bim[4]; \
        { u32x4 uw = (u32x4){0u, 0u, 0u, 0u}; \
          if (q4 < 2) { const f32x4 ua = *(const LAS f32x4*)((UT) + l15 * 16 + 8 * q4), ubv = *(const LAS f32x4*)((UT) + l15 * 16 + 8 * q4 + 4); \
              uw.x = cvt_pk_bf16(ua[0], ua[1]); uw.y = cvt_pk_bf16(ua[2], ua[3]); uw.z = cvt_pk_bf16(ubv[0], ubv[1]); uw.w = cvt_pk_bf16(ubv[2], ubv[3]); } \
          const bf16x8 uf = __builtin_bit_cast(bf16x8, uw); \
          _Pragma("unroll") for (int nb = 0; nb < 8; ++nb) { const f32x4 d = __builtin_amdgcn_mfma_f32_16x16x32_bf16(uf, bfr[nb], (f32x4){0.f, 0.f, 0.f, 0.f}, 0, 0, 0); \
              *(LAS f32x4*)(but + (16 * nb + l15) * 20 + 4 * q4) = d; } \
          _Pragma("unroll") for (int k = 0; k < 4; ++k) { bre[k] = *(const LAS f32x4*)(but + lane * 20 + 4 * k); bim[k] = *(const LAS f32x4*)(but + (64 + lane) * 20 + 4 * k); } }
#define SSM_UPD(tt) do { const float _br = bre[(tt) >> 2][(tt) & 3], _bi = bim[(tt) >> 2][(tt) & 3]; \
        const float _nr = fmaf(lr, xr, fmaf(-li, xi, _br)), _ni = fmaf(lr, xi, fmaf(li, xr, _bi)); xr = _nr; xi = _ni; } while (0)
    float xr = 0.f, xi = 0.f;
    SSM_STOREU(0, 0);
#pragma unroll
    for (int sub = 0; sub < SSM_SUBS; ++sub) {
        const LAS float* u = ub + (sub & 1) * 1024;
        if (sub < SSM_SUBS - 1) SSM_STOREU((sub + 1) & 1, sub + 1);
_Pragma("unroll 1")
        for (int tile = 0; tile < 4; ++tile) {
            SSM_TILE_BU(u + tile * 256);
#pragma unroll
            for (int tt = 0; tt < 16; ++tt) SSM_UPD(tt);
        }
    }
    if (epoch > 1u) for (int j = 0; j < SSM_NW; ++j) while (flags[4 + j] != epoch - 1u) __builtin_amdgcn_s_sleep(1);
    sb[(wave * 64 + lane) * 2] = xr; sb[(wave * 64 + lane) * 2 + 1] = xi;
    LDS_WAIT();
    __builtin_amdgcn_fence(__ATOMIC_RELEASE, "workgroup");
    if (lane == 0) flags[wave] = epoch;
    float cr = 0.f, ci = 0.f;
    for (int j = 0; j < wave; ++j) {
        while (flags[j] != epoch) __builtin_amdgcn_s_sleep(1);
        __builtin_amdgcn_fence(__ATOMIC_ACQUIRE, "workgroup");
        const float sr = sb[(j * 64 + lane) * 2], si = sb[(j * 64 + lane) * 2 + 1];
        const float nr = pr * cr - pi * ci + sr, ni = pr * ci + pi * cr + si; cr = nr; ci = ni; }
    if (lane == 0) flags[4 + wave] = epoch;
    bf16x8 cf[4]; ssm_cfrag(g, lane, in[I_CRE], in[I_CIM], cf);
    const int h = l15, tq = q4;
    const float dsk = in[I_SSMD][g * 16 + h];
    xr = cr; xi = ci;
    SSM_STOREU(0, 0);
#pragma unroll
    for (int sub = 0; sub < SSM_SUBS; ++sub) {
        const LAS float* u = ub + (sub & 1) * 1024;
        if (sub < SSM_SUBS - 1) SSM_STOREU((sub + 1) & 1, sub + 1);
_Pragma("unroll 1")
        for (int tile = 0; tile < 4; ++tile) {
            SSM_TILE_BU(u + tile * 256);
#pragma unroll
            for (int tt = 0; tt < 16; ++tt) { SSM_UPD(tt); xt[tt * 68 + lane] = cvt_pk_bf16(xr, xi); }
            f32x4 acc = (f32x4){0.f, 0.f, 0.f, 0.f};
#pragma unroll
            for (int ks = 0; ks < 4; ++ks) { const bf16x8 a = *(const LAS bf16x8*)(xt + h * 68 + 4 * tq + 16 * ks); acc = __builtin_amdgcn_mfma_f32_16x16x32_bf16(a, cf[ks], acc, 0, 0, 0); }
#pragma unroll
            for (int r = 0; r < 4; ++r) { const int tl = tile * 16 + 4 * tq + r; const float y = acc[r] + dsk * u[tl * 16 + h];
                GS[(row0 + sub * 64 + tl) * 1024 + g * 16 + h] = (bf16_t)(cvt_pk_bf16(gelu_tanh(y), 0.f) & 0xffff); }
        }
    }
    if (wave == SSM_NW - 1) { out_re[(size_t)(b * 64 + g) * 64 + lane] = xr; out_im[(size_t)(b * 64 + g) * 64 + lane] = xi; }
#undef SSM_STOREU
#undef SSM_TILE_BU
#undef SSM_UPD
}
__device__ __forceinline__ void ssm_sample_unit(int g, int bq, const float* US, bf16_t* GS, const float* st_re, const float* st_im, float* out_re, float* out_im, const float* const* in,
                                                LAS unsigned char* lds, int wave, int lane) {
    float lr, li, pr, pi; float bbr[16], bbi[16];
    ssm_params(g, lane, in[I_ARE], in[I_AIM], in[I_LOGSTEP], in[I_BRE], in[I_BIM], lr, li, pr, pi, bbr, bbi);
    LAS float* ub = (LAS float*)(lds + wave * SSM_WSTRIDE);
    LAS unsigned* xt = (LAS unsigned*)(lds + wave * SSM_WSTRIDE + 8192);
    { const int i = lane >> 2, part = lane & 3; *(LAS f32x4*)(ub + lane * 4) = ld4bf((const bf16_t*)US + us_off((size_t)(MP + bq * 16 + i), g * 16 + part * 4)); }
    for (int i = 0; i < 16; ++i) {
        const int b = bq * 16 + i; const size_t so = (size_t)(b * 64 + g) * 64 + lane;
        float xr = st_re[so], xi = st_im[so];
        SSM_STEP(ub + i * 16);
        out_re[so] = xr; out_im[so] = xi;
        xt[i * 68 + lane] = cvt_pk_bf16(xr, xi);
    }
    bf16x8 cf[4]; ssm_cfrag(g, lane, in[I_CRE], in[I_CIM], cf);
    const int h = lane & 15, tq = lane >> 4;
    const float dsk = in[I_SSMD][g * 16 + h];
    f32x4 acc = (f32x4){0.f, 0.f, 0.f, 0.f};
#pragma unroll
    for (int ks = 0; ks < 4; ++ks) { const bf16x8 a = *(const LAS bf16x8*)(xt + h * 68 + 4 * tq + 16 * ks); acc = __builtin_amdgcn_mfma_f32_16x16x32_bf16(a, cf[ks], acc, 0, 0, 0); }
#pragma unroll
    for (int r = 0; r < 4; ++r) { const int i = 4 * tq + r; const float y = acc[r] + dsk * ub[i * 16 + h];
        GS[(size_t)(MP + bq * 16 + i) * 1024 + g * 16 + h] = (bf16_t)(cvt_pk_bf16(gelu_tanh(y), 0.f) & 0xffff); }
}

__device__ __forceinline__ void attn_load_img(LAS unsigned char* img, const bf16_t* base, int row_stride, int tid) {
#pragma unroll 4
    for (int it = 0; it < 16; ++it) { const int cidx = it * NTHREADS + tid, row = cidx >> 5, c16 = cidx & 31;
        const u32x4 v = *(const u32x4*)(base + (size_t)row * row_stride + c16 * 8);
        *(LAS u32x4*)(img + row * 512 + ((c16 ^ (row & 15)) << 4)) = v; }
}
__device__ __forceinline__ void attn_prompt_unit(int b, int hd, int qb, const bf16_t* Q, const bf16_t* KB, const bf16_t* VT, bf16_t* XO, LAS unsigned char* lds, int tid, int wave, int lane) {
    const int l15 = lane & 15, h4 = lane >> 4;
    const size_t qrow = (size_t)b * SEQ + qb * 128 + wave * 16 + l15;
    bf16x8 qf[8];
#pragma unroll
    for (int ks = 0; ks < 8; ++ks) qf[ks] = *(const bf16x8*)(Q + qrow * 1024 + hd * 256 + 32 * ks + 8 * h4);
    attn_load_img(lds, KB + (size_t)b * NMEM * 1024 + hd * 256, 1024, tid);
    __syncthreads();
    f32x4 sa[16];
#pragma unroll
    for (int nb = 0; nb < 16; ++nb) {
        f32x4 acc = (f32x4){0.f, 0.f, 0.f, 0.f};
#pragma unroll
        for (int ks = 0; ks < 8; ++ks) { const bf16x8 a = *(const LAS bf16x8*)(lds + (16 * nb + l15) * 512 + (((4 * ks + h4) ^ l15) << 4));
            acc = __builtin_amdgcn_mfma_f32_16x16x32_bf16(a, qf[ks], acc, 0, 0, 0); }
        sa[nb] = acc;
    }
    float mx = -3.0e38f;
#pragma unroll
    for (int nb = 0; nb < 16; ++nb) mx = fmaxf(fmaxf(mx, fmaxf(sa[nb][0], sa[nb][1])), fmaxf(sa[nb][2], sa[nb][3]));
    mx = fmaxf(mx, __shfl_xor(mx, 16)); mx = fmaxf(mx, __shfl_xor(mx, 32));
    float sum = 0.f;
#pragma unroll
    for (int nb = 0; nb < 16; ++nb) {
#pragma unroll
        for (int r = 0; r < 4; ++r) { const float p = __expf(sa[nb][r] - mx); sa[nb][r] = p; sum += p; } }
    sum += __shfl_xor(sum, 16); sum += __shfl_xor(sum, 32);
    const float inv = 1.0f / sum;
    bf16x8 pf[8];
#pragma unroll
    for (int ks = 0; ks < 8; ++ks) { u32x4 w; w.x = cvt_pk_bf16(sa[2 * ks][0], sa[2 * ks][1]); w.y = cvt_pk_bf16(sa[2 * ks][2], sa[2 * ks][3]);
        w.z = cvt_pk_bf16(sa[2 * ks + 1][0], sa[2 * ks + 1][1]); w.w = cvt_pk_bf16(sa[2 * ks + 1][2], sa[2 * ks + 1][3]); pf[ks] = __builtin_bit_cast(bf16x8, w); }
    __syncthreads();
    attn_load_img(lds, VT + (size_t)(b * 4 + hd) * 256 * 256, 256, tid);
    __syncthreads();
#pragma unroll
    for (int db = 0; db < 16; ++db) {
        f32x4 acc = (f32x4){0.f, 0.f, 0.f, 0.f};
#pragma unroll
        for (int ks = 0; ks < 8; ++ks) {
            const LAS unsigned char* rp = lds + (16 * db + l15) * 512;
            const u32x2 lo = *(const LAS u32x2*)(rp + (((8 * ks + h4) ^ (l15 << 1)) << 3)), hi = *(const LAS u32x2*)(rp + (((8 * ks + 4 + h4) ^ (l15 << 1)) << 3));
            u32x4 w; w.x = lo.x; w.y = lo.y; w.z = hi.x; w.w = hi.y;
            acc = __builtin_amdgcn_mfma_f32_16x16x32_bf16(__builtin_bit_cast(bf16x8, w), pf[ks], acc, 0, 0, 0);
        }
        u32x2 o; o.x = cvt_pk_bf16(acc[0] * inv, acc[1] * inv); o.y = cvt_pk_bf16(acc[2] * inv, acc[3] * inv);
        *(u32x2*)(XO + qrow * 1024 + hd * 256 + 16 * db + 4 * h4) = o;
    }
    __syncthreads();
}
__device__ __forceinline__ float red16(float (&p)[16], int lane) {
#pragma unroll
    for (int k = 0; k < 8; ++k) { const float a = p[k], b = p[k + 8]; const float snd = (lane & 32) ? a : b, keep = (lane & 32) ? b : a; p[k] = keep + __shfl_xor(snd, 32); }
#pragma unroll
    for (int k = 0; k < 4; ++k) { const float a = p[k], b = p[k + 4]; const float snd = (lane & 16) ? a : b, keep = (lane & 16) ? b : a; p[k] = keep + __shfl_xor(snd, 16); }
#pragma unroll
    for (int k = 0; k < 2; ++k) { const float a = p[k], b = p[k + 2]; const float snd = (lane & 8) ? a : b, keep = (lane & 8) ? b : a; p[k] = keep + __shfl_xor(snd, 8); }
    { const float a = p[0], b = p[1]; const float snd = (lane & 4) ? a : b, keep = (lane & 4) ? b : a; p[0] = keep + __shfl_xor(snd, 4); }
    float r = p[0]; r += __shfl_xor(r, 2); r += __shfl_xor(r, 1);
    return r;
}
__device__ __forceinline__ void attn_sample_half(int b, int hd, int kh, int rot, const bf16_t* Q, const float* CK, const float* CV, bf16_t* XO, LAS float* xch, volatile LAS unsigned* flag, unsigned epoch, int lane) {
    f32x4 q4; { const u32x2 qv = *(const u32x2*)(Q + (size_t)(MP + b) * 1024 + hd * 256 + 4 * lane);
        q4[0] = __uint_as_float(qv.x << 16); q4[1] = __uint_as_float(qv.x & 0xffff0000u); q4[2] = __uint_as_float(qv.y << 16); q4[3] = __uint_as_float(qv.y & 0xffff0000u); }
    const float* kbase = CK + ((size_t)b * NMEM * 4 + hd) * 256 + 4 * lane + (size_t)(kh * 128) * 1024;
    const float* vbase = CV + ((size_t)b * NMEM * 4 + hd) * 256 + 4 * lane + (size_t)(kh * 128) * 1024;
    float sc[8];
#pragma unroll
    for (int i = 0; i < 8; ++i) {
        const int bt = (i + rot) & 7;
        f32x4 kv[16];
#pragma unroll
        for (int j = 0; j < 16; ++j) kv[j] = __builtin_nontemporal_load((const f32x4*)(kbase + (size_t)(bt * 16 + j) * 1024));
        float p[16];
#pragma unroll
        for (int j = 0; j < 16; ++j) p[j] = (kv[j][0] * q4[0] + kv[j][1] * q4[1]) + (kv[j][2] * q4[2] + kv[j][3] * q4[3]);
        sc[i] = red16(p, lane);
    }
    float mx = sc[0];
#pragma unroll
    for (int i = 1; i < 8; ++i) mx = fmaxf(mx, sc[i]);
    mx = wave_max(mx);
    float sum = 0.f;
#pragma unroll
    for (int i = 0; i < 8; ++i) { sc[i] = __expf(sc[i] - mx); sum += sc[i]; }
    sum = wave_sum(sum) * 0.25f;
    f32x4 o = (f32x4){0.f, 0.f, 0.f, 0.f};
#pragma unroll
    for (int i = 0; i < 8; ++i) {
        const int bt = (i + rot) & 7;
        f32x4 vv[16];
#pragma unroll
        for (int j = 0; j < 16; ++j) vv[j] = __builtin_nontemporal_load((const f32x4*)(vbase + (size_t)(bt * 16 + j) * 1024));
#pragma unroll
        for (int j = 0; j < 16; ++j) { const float pj = __shfl(sc[i], 4 * j); o += vv[j] * pj; }
    }
    if (kh == 1) {
        if (epoch > 1u) while (flag[4] != epoch - 1u) __builtin_amdgcn_s_sleep(1);
        *(LAS f32x4*)(xch + 4 * lane) = o; if (lane == 0) { xch[256] = mx; xch[257] = sum; }
        LDS_WAIT();
        __builtin_amdgcn_fence(__ATOMIC_RELEASE, "workgroup");
        if (lane == 0) *flag = epoch;
    } else {
        while (*flag != epoch) __builtin_amdgcn_s_sleep(1);
        __builtin_amdgcn_fence(__ATOMIC_ACQUIRE, "workgroup");
        const volatile LAS float* xv = xch;
        const float mB = xv[256], lB = xv[257];
        f32x4 oB; oB[0] = xv[4 * lane]; oB[1] = xv[4 * lane + 1]; oB[2] = xv[4 * lane + 2]; oB[3] = xv[4 * lane + 3];
        const float M = fmaxf(mx, mB), fa = __expf(mx - M), fb = __expf(mB - M);
        const float inv = 1.0f / (sum * fa + lB * fb);
        o = (o * fa + oB * fb) * inv;
        u32x2 w; w.x = cvt_pk_bf16(o[0], o[1]); w.y = cvt_pk_bf16(o[2], o[3]);
        *(u32x2*)(XO + (size_t)(MP + b) * 1024 + hd * 256 + 4 * lane) = w;
        if (lane == 0) flag[4] = epoch;
    }
}

#define XB_TMO      128
#define XB_XCNT(j)  (256  + 64 * (j))
#define XB_XSUB(j)  (1280 + 64 * (j))
#define XB_XGEN(j)  (2304 + 64 * (j))
#define XB_TOP      3328
#define XB_TOPGEN   3392
#define XCD_BAR_WORDS 3456
#define XB_SPIN_CAP (1u << 18)
__device__ __forceinline__ unsigned xb_ld(unsigned* p)              { return __hip_atomic_load(p, __ATOMIC_RELAXED, __HIP_MEMORY_SCOPE_AGENT); }
__device__ __forceinline__ unsigned xb_add(unsigned* p, unsigned v) { return __hip_atomic_fetch_add(p, v, __ATOMIC_RELAXED, __HIP_MEMORY_SCOPE_AGENT); }
__device__ __forceinline__ unsigned xb_xcc_id() { return (unsigned)__builtin_amdgcn_s_getreg((3 << 11) | 20) & 0xFu; }
#define XB_SPIN(cond, bar) do { unsigned _sp = 0; while (cond) { __builtin_amdgcn_s_sleep(1); \
    if ((++_sp & 255u) == 0u) { if (xb_ld(&(bar)[XB_TMO])) break; if (_sp > XB_SPIN_CAP) { atomicAdd(&(bar)[XB_TMO], 1u); break; } } } } while (0)
struct XcdBarrier { unsigned* bar; unsigned x; volatile LAS unsigned* st; };
__device__ __forceinline__ XcdBarrier xcd_barrier_post(unsigned* bar, volatile LAS unsigned* st) {
    XcdBarrier b; b.bar = bar; b.x = xb_xcc_id(); b.st = st;
    if (threadIdx.x == 0) (void)xb_add(&bar[XB_XCNT(b.x)], 1u);
    return b;
}
__device__ __forceinline__ void xcd_barrier_complete(unsigned* bar, unsigned x, unsigned& nloc, unsigned& nx) {
    const unsigned G = gridDim.x * gridDim.y * gridDim.z;
    unsigned sum, cnt, mine, sp = 0u;
    for (;;) {
        sum = 0u; cnt = 0u; mine = 0u;
#pragma unroll
        for (unsigned j = 0; j < 16; ++j) { const unsigned c = xb_ld(&bar[XB_XCNT(j)]); sum += c; cnt += (c > 0u) ? 1u : 0u; mine = (j == x) ? c : mine; }
        if (sum == G) break;
        __builtin_amdgcn_s_sleep(1);
        if ((++sp & 255u) == 0u) { if (xb_ld(&bar[XB_TMO])) break; if (sp > XB_SPIN_CAP) { atomicAdd(&bar[XB_TMO], 1u); break; } }
    }
    nloc = mine > 0u ? mine : 1u; nx = cnt > 0u ? cnt : 1u;
}
__device__ __forceinline__ void xcd_barrier(const XcdBarrier& b) {
    asm volatile("s_waitcnt vmcnt(0)" ::: "memory");
    __syncthreads();
    if (threadIdx.x == 0) {
        unsigned* bar = b.bar;
        __builtin_amdgcn_s_waitcnt(0);
        unsigned nloc = b.st[0], nx = b.st[1];
        if (nloc == 0u) { xcd_barrier_complete(bar, b.x, nloc, nx); b.st[0] = nloc; b.st[1] = nx; }
        const unsigned old = xb_add(&bar[XB_XSUB(b.x)], 1u);
        const unsigned gen = old / nloc;
        if (old + 1u == (gen + 1u) * nloc) {
            __builtin_amdgcn_fence(__ATOMIC_RELEASE, "agent");
            asm volatile("s_waitcnt vmcnt(0)" ::: "memory");
            const unsigned og = xb_add(&bar[XB_TOP], 1u);
            const unsigned tg = og / nx;
            if (og + 1u == (tg + 1u) * nx) xb_add(&bar[XB_TOPGEN], 1u);
            else XB_SPIN(xb_ld(&bar[XB_TOPGEN]) == tg, bar);
            xb_add(&bar[XB_XGEN(b.x)], 1u);
            __builtin_amdgcn_fence(__ATOMIC_ACQUIRE, "agent");
            asm volatile("s_waitcnt vmcnt(0)" ::: "memory");
        } else {
            asm volatile("buffer_inv sc1" ::: "memory");
            XB_SPIN(xb_ld(&bar[XB_XGEN(b.x)]) == gen, bar);
            asm volatile("s_waitcnt vmcnt(0)" ::: "memory");
        }
    }
    __syncthreads();
}
__device__ __forceinline__ void wait_count(unsigned* ctr, unsigned target) {
    if (threadIdx.x == 0) { unsigned sp = 0; while (xb_ld(ctr) < target) { __builtin_amdgcn_s_sleep(1); if (++sp > (1u << 22)) break; }
        __builtin_amdgcn_fence(__ATOMIC_ACQUIRE, "agent"); asm volatile("s_waitcnt vmcnt(0)" ::: "memory"); }
    __syncthreads();
}
constexpr int MISC_OFF = LDS_BYTES - 128;
constexpr size_t CTL_ZERO_BYTES = 65536;
constexpr int CW_BAR = 1024;
constexpr int CW_P8 = 9216;

__global__ void __launch_bounds__(NTHREADS, 2) mk_fwd(Args args) {
    extern __shared__ __attribute__((aligned(16))) unsigned char lds_raw[];
    LAS unsigned char* lds = (LAS unsigned char*)lds_raw;
    const int tid = threadIdx.x, lane = tid & 63, wave = __builtin_amdgcn_readfirstlane(tid >> 6);
    const int G = gridDim.x, bx = blockIdx.x;
    const int gw = bx * NWAVES + wave, ngw = G * NWAVES;
    const int gtid = bx * NTHREADS + tid, ngt = G * NTHREADS;
    unsigned char* ws = args.ws;
    const float* const* in = args.in;
    float* out = args.out;
    bf16_t* W1GU = (bf16_t*)(ws + WS_W1GU); bf16_t* W1D = (bf16_t*)(ws + WS_W1D); bf16_t* WIN = (bf16_t*)(ws + WS_WIN); bf16_t* WPG = (bf16_t*)(ws + WS_WPG);
    bf16_t* WPO = (bf16_t*)(ws + WS_WPO); bf16_t* WGLU = (bf16_t*)(ws + WS_WGLU); bf16_t* WXO = (bf16_t*)(ws + WS_WXO); bf16_t* WOUT = (bf16_t*)(ws + WS_WOUT);
    bf16_t* WMKV = (bf16_t*)(ws + WS_WMKV); bf16_t* W2GU = (bf16_t*)(ws + WS_W2GU); bf16_t* W2D = (bf16_t*)(ws + WS_W2D);
    bf16_t* XN = (bf16_t*)(ws + WS_XN); bf16_t* ACT = (bf16_t*)(ws + WS_ACT); bf16_t* GT = (bf16_t*)(ws + WS_ACT); float* F = (float*)(ws + WS_F); float* H = (float*)(ws + WS_H);
    float* UP = (float*)(ws + WS_UP); float* US = (float*)(ws + WS_US); bf16_t* Q = (bf16_t*)(ws + WS_Q); bf16_t* DIFF = (bf16_t*)(ws + WS_DIFF); bf16_t* WPO2 = (bf16_t*)(ws + WS_Z); bf16_t* WPGS = (bf16_t*)(ws + WS_Z + 8 * MiB); bf16_t* WPGO = (bf16_t*)(ws + WS_Z + 12 * MiB);
    bf16_t* GS = (bf16_t*)(ws + WS_GS); bf16_t* XO = (bf16_t*)(ws + WS_XO); bf16_t* MB = (bf16_t*)(ws + WS_MB); bf16_t* MEMN = (bf16_t*)(ws + WS_MEMN);
    bf16_t* KB = (bf16_t*)(ws + WS_KB); bf16_t* VT = (bf16_t*)(ws + WS_VT); float* SLAB = (float*)(ws + WS_SLAB); float* SLAB7 = (float*)(ws + WS_SLAB7);
    const int lo = args.ph_lo, hi = args.ph_hi;
    LAS float* scr = (LAS float*)(lds + wave * 16640);
    constexpr int IT_GU = (DM / 64) * (DFF / 64), IT_D = IT_GU, IT_IN = (DM / 64) * (9216 / 64), IT_IN_P0 = 2816, IT_PG = 16, IT_1K2K = (1024 / 64) * (2048 / 64), IT_2K1K = IT_1K2K, IT_OUT = 32 * 32;
#define TAIL_BEGIN(units) { const int busy_ = (units) % G; if (bx >= busy_) { const int tw = (bx - busy_) * NWAVES + wave, ntw = (G - busy_) * NWAVES;
#define TAIL_END } }
#if MK_SINGLE
    for (int i = tid; i < LDS_BYTES / 16; i += NTHREADS) ((LAS u32x4*)lds)[i] = (u32x4){0u, 0u, 0u, 0u};
    __syncthreads();
    const XcdBarrier xbar = xcd_barrier_post((unsigned*)ws + CW_BAR, (volatile LAS unsigned*)(lds + MISC_OFF) + 8);
#define GRID_BAR() xcd_barrier(xbar)
#else
#define GRID_BAR() do { } while (0)
#endif
#define IN(k) (lo <= (k) && (k) < hi)
#define SEAM(k) do { if (IN(k) && IN((k) + 1)) GRID_BAR(); } while (0)

    if (IN(0)) {
        constexpr int NITEMS = 2 * IT_GU + IT_IN_P0 + 2 * IT_2K1K;
        for (int it = gw; it < NITEMS; it += ngw) {
            int r = it;
            if (cvt_mat(r, in[I_W1G], DM, DFF, W1GU, 1, 0, scr, lane)) continue;
            if (cvt_mat(r, in[I_W1U], DM, DFF, W1GU, 1, 128, scr, lane)) continue;
            if (cvt_mat(r, in[I_WMK], DM, 1024, WMKV, 0, 0, scr, lane)) continue;
            if (cvt_mat(r, in[I_WMV], DM, 1024, WMKV, 0, 1024, scr, lane)) continue;
            cvt_mat(r, in[I_WIN], DM, 9216, WIN, 0, 0, scr, lane);
        }
        for (int m = gw; m < MT; m += ngw) rms_row_bf16(xrow_ptr(in[I_XP], in[I_XS], m), in[I_G1PRE], XN + (size_t)m * DM, lane);
        for (int m = gw; m < MEMR; m += ngw) rms_row_bf16(in[I_MEM] + (size_t)m * DM, in[I_GMEM], MEMN + (size_t)m * DM, lane);
    }
    SEAM(0);
    if (IN(1)) {
        pg8::Sched2 S; S.A0 = (const char*)XN; S.B0 = (const char*)W1GU; S.nM0 = NMT; S.nN0 = 2 * DFF / 256; S.nt0 = DM / 64; S.ta0 = (size_t)256 * DM * 2; S.tb0 = (size_t)256 * DM * 2; S.ca0 = 0;
        S.A1 = (const char*)MEMN; S.B1 = (const char*)WMKV; S.nM1 = MEMR / 256; S.nN1 = 8; S.nt1 = DM / 64; S.ta1 = (size_t)256 * DM * 2; S.tb1 = (size_t)256 * DM * 2; S.ca1 = 0; S.G = G; S.c = bx;
        pg8::EpiUp E; E.ACT = ACT; E.outK = out + O_MK; E.outV = out + O_MV; E.KB = KB; E.VT = VT;
        pg8::gemm_phase(lds, DM, DM, S, E);
        TAIL_BEGIN(NMT * (2 * DFF / 256) + (MEMR / 256) * 8)
            for (int it = tw; it < IT_D + (IT_IN - IT_IN_P0); it += ntw) { int r = it;
                if (cvt_mat<64>(r, in[I_W1D], DFF, DM, W1D, 0, 0, scr, lane)) continue;
                r += IT_IN_P0; cvt_mat<64>(r, in[I_WIN], DM, 9216, WIN, 0, 0, scr, lane); }
        TAIL_END
    }
    SEAM(1);
    if (IN(2)) {
        pg8::SchedN2 S; S.A = (const char*)ACT; S.B = (const char*)W1D; S.nt = DFF / 64; S.ta = (size_t)256 * DFF * 2; S.tb = (size_t)256 * DFF * 2; S.G = G; S.c = bx; S.minis = true;
        pg8::EpiF32 E; E.F = F; E.SLAB = SLAB;
        pg8::gemm_phase(lds, DFF, DFF, S, E);
        TAIL_BEGIN(256 + 8 * (DFF / 256))
            constexpr int NIT = 2 * IT_1K2K;
            for (int it = tw; it < NIT; it += ntw) {
                int r = it;
                if (cvt_mat<64>(r, in[I_WPO], 1024, DM, WPO2, 0, 0, scr, lane, DM)) continue;
                cvt_mat<64>(r, in[I_WXO], 1024, DM, WXO, 0, 0, scr, lane);
            }
            for (int q = tw * 64 + lane; q < 4 * 256 * 32; q += ntw * 64) {
                const int row = q >> 5, d0 = (q & 31) * 8; const float* wp = in[I_WPG] + (size_t)row * 256 + d0; const float* sp = in[I_PSCALE] + (row >> 8) * 256 + d0;
                *(u32x4*)(WPGS + (size_t)row * DM + d0) = pg8::pack8(*(const f32x4*)wp * *(const f32x4*)sp, *(const f32x4*)(wp + 4) * *(const f32x4*)(sp + 4));
            }
        TAIL_END
    }
    SEAM(2);
    if (IN(3)) { rowop_sample<0>(bx, G, wave, lane, lds, SLAB, DFF / 256, in[I_XS], H, in[I_G1POST], in[I_GMIXPRE], XN, nullptr);
        rowop<0>(gw, ngw, lane, F, SLAB, DFF / 256, in[I_XP], in[I_XS], H, in[I_G1POST], in[I_GMIXPRE], XN, nullptr); }
    SEAM(3);
    if (IN(4)) {
        pg8::Sched2 S; S.A0 = (const char*)XN; S.B0 = (const char*)WIN; S.nM0 = NMT; S.nN0 = 36; S.nt0 = DM / 64; S.ta0 = (size_t)256 * DM * 2; S.tb0 = (size_t)256 * DM * 2; S.ca0 = 0;
        S.A1 = (const char*)WPO2; S.B1 = (const char*)WPGS; S.nM1 = 8; S.nN1 = 4; S.nt1 = 4; S.ta1 = (size_t)256 * DM * 2; S.tb1 = (size_t)256 * DM * 2; S.ca1 = 512; S.G = G; S.c = bx;
        pg8::EpiIn E; E.UP = UP; E.US = US; E.Q = Q; E.G = GT; E.WPGO = WPGO;
        pg8::gemm_phase(lds, DM, DM, S, E);
        TAIL_BEGIN(NMT * 36)
            constexpr int NIT = 2 * IT_1K2K + IT_OUT + IT_GU;
            for (int it = tw; it < NIT; it += ntw) {
                int r = it;
                if (cvt_mat<64>(r, in[I_WGV], 1024, DM, WGLU, 1, 0, scr, lane)) continue;
                if (cvt_mat<64>(r, in[I_WGG], 1024, DM, WGLU, 1, 128, scr, lane)) continue;
                if (cvt_mat<64>(r, in[I_WOUT], DM, DM, WOUT, 0, 0, scr, lane)) continue;
                cvt_mat<64>(r, in[I_W2G], DM, DFF, W2GU, 1, 0, scr, lane);
            }
        TAIL_END
    }
    SEAM(4);
    if (IN(5)) {
        LAS unsigned* MISCW = (LAS unsigned*)(lds + MISC_OFF);
        if (wave < SSM_NW) {
            volatile LAS unsigned* flags = (volatile LAS unsigned*)MISCW + 16;
            unsigned epoch = 1;
            for (int un = bx; un < NBAT * 64; un += G, ++epoch) ssm_prompt_unit(un >> 6, un & 63, US, GS, out + O_SRP, out + O_SIP, in, lds, flags, epoch, wave, lane);
            for (int un = bx * SSM_NW + wave; un < 64 * 8; un += G * SSM_NW) ssm_sample_unit(un >> 3, un & 7, US, GS, in[I_SRE], in[I_SIM], out + O_SRS, out + O_SIS, in, lds, wave, lane);
        } else {
            const int pr = (wave - 4) >> 1, kh = (wave - 4) & 1;
            __builtin_amdgcn_s_setprio(2);
            LAS float* xch = (LAS float*)(lds + 98304 + pr * 2048);
            unsigned epoch = 1;
            for (int un = bx * 2 + pr; un < MS * 4; un += G * 2, ++epoch)
                attn_sample_half(un >> 2, un & 3, kh, (un * 5) & 7, Q, in[I_CK], in[I_CV], XO, xch, (volatile LAS unsigned*)MISCW + 24 + pr, epoch, lane);
        }
        __builtin_amdgcn_s_setprio(0);
        pool_steal(bx, G, MISCW + 26, lane, UP, in[I_SPOOL], DIFF, out + O_PP, out + O_PS);
        __syncthreads();
        for (int un = bx; un < NBAT * 4 * 16; un += G) attn_prompt_unit(un >> 6, (un >> 4) & 3, un & 15, Q, KB, VT, XO, lds, tid, wave, lane);
    }
    SEAM(5);
    if (IN(7)) {
        pg8::SchedBr S; S.Z = (const char*)DIFF; S.XO = (const char*)XO; S.GS = (const char*)GS; S.WPO = (const char*)WPGO; S.WXO = (const char*)WXO; S.WGLU = (const char*)WGLU; S.G = G; S.c = bx;
        pg8::EpiBr E; E.MG = F; E.MB = MB; E.G = GT; E.SLAB7 = SLAB7;
        pg8::gemm_phase(lds, 1024, 1024, S, E);
        TAIL_BEGIN(256 + 128)
            for (int it = tw; it < IT_GU / 2; it += ntw) { int r = it; cvt_mat<64>(r, in[I_W2U], DM, DFF, W2GU, 1, 128, scr, lane); }
        TAIL_END
    }
    SEAM(7);
    if (IN(8)) {
        for (int idx = gtid; idx < MS * 256; idx += ngt) {
            const int r = idx >> 8, c0 = (idx & 255) * 8, bt = c0 >> 7, wi = c0 & 127;
            f32x4 po[2] = {}, xa[2] = {}, va[2] = {}, ga[2] = {};
#pragma unroll
            for (int kc = 0; kc < 4; ++kc) { const float* sr = SLAB7 + ((size_t)kc * 128 + r) * 8192;
#pragma unroll
                for (int q = 0; q < 2; ++q) { po[q] += *(const f32x4*)(sr + c0 + 4 * q); xa[q] += *(const f32x4*)(sr + 2048 + c0 + 4 * q);
                    va[q] += *(const f32x4*)(sr + 4096 + bt * 256 + wi + 4 * q); ga[q] += *(const f32x4*)(sr + 4096 + bt * 256 + 128 + wi + 4 * q); } }
            const bf16_t* gr = GT + pg8::frag_off(32 * 24 + (c0 >> 8), 0, (r >> 4) & 3, (c0 >> 7) & 1, (r >> 6) & 1, (c0 >> 5) & 3, r & 15, (c0 >> 3) & 3);
            f32x4 g0a, g0b, g1a, g1b, g2a, g2b; pg8::unpack8(*(const u32x4*)gr, g0a, g0b); pg8::unpack8(*(const u32x4*)(gr + (size_t)8 * 65536), g1a, g1b); pg8::unpack8(*(const u32x4*)(gr + (size_t)16 * 65536), g2a, g2b);
            f32x4 o0, o1;
#pragma unroll
            for (int j = 0; j < 4; ++j) { o0[j] = g0a[j] * po[0][j] + g2a[j] * xa[0][j] + g1a[j] * va[0][j] * sigm(ga[0][j]); o1[j] = g0b[j] * po[1][j] + g2b[j] * xa[1][j] + g1b[j] * va[1][j] * sigm(ga[1][j]); }
            { const u32x4 w_ = pg8::pack8(o0, o1); void* p_ = MB + (size_t)(MP + r) * DM + c0;
              asm volatile("s_nop 0\n\tglobal_store_dwordx4 %0, %1, off sc1\n\ts_nop 1" :: "v"(p_), "v"(w_) : "memory"); }
        }
        asm volatile("s_waitcnt vmcnt(0)" ::: "memory");
        __syncthreads();
        if (tid == 0) (void)xb_add((unsigned*)ws + CW_P8, 1u);
        {
            pg8::SchedN2 S; S.A = (const char*)MB; S.B = (const char*)WOUT; S.nt = DM / 64; S.ta = (size_t)256 * DM * 2; S.tb = (size_t)256 * DM * 2; S.G = G; S.c = bx; S.minis = false;
            pg8::EpiF32 E; E.F = F; E.SLAB = SLAB;
            pg8::gemm_phase(lds, DM, DM, S, E);
        }
        if (bx < 8 * (DM / 256)) {
            wait_count((unsigned*)ws + CW_P8, (unsigned)G);
            pg8::SchedMini S; S.A = (const char*)MB; S.B = (const char*)WOUT; S.nt = DM / 64; S.ta = (size_t)256 * DM * 2; S.tb = (size_t)256 * DM * 2; S.c = bx;
            pg8::EpiF32 E; E.F = F; E.SLAB = SLAB;
            pg8::gemm_phase(lds, DM, DM, S, E);
        }
        TAIL_BEGIN(256 + 8 * (DM / 256))
            for (int it = IT_GU / 2 + tw; it < IT_GU; it += ntw) { int r = it; cvt_mat<64>(r, in[I_W2U], DM, DFF, W2GU, 1, 128, scr, lane); }
        TAIL_END
    }
    SEAM(9);
    if (IN(10)) { rowop_sample<1>(bx, G, wave, lane, lds, SLAB, DM / 256, nullptr, H, in[I_GMIXPOST], in[I_G2PRE], XN, nullptr);
        rowop<1>(gw, ngw, lane, F, SLAB, DM / 256, nullptr, nullptr, H, in[I_GMIXPOST], in[I_G2PRE], XN, nullptr); }
    SEAM(10);
    if (IN(11)) {
        pg8::Sched2 S; S.A0 = (const char*)XN; S.B0 = (const char*)W2GU; S.nM0 = NMT; S.nN0 = 2 * DFF / 256; S.nt0 = DM / 64; S.ta0 = (size_t)256 * DM * 2; S.tb0 = (size_t)256 * DM * 2; S.ca0 = 0;
        S.A1 = nullptr; S.B1 = nullptr; S.nM1 = 0; S.nN1 = 0; S.nt1 = 0; S.ta1 = 0; S.tb1 = 0; S.ca1 = 0; S.G = G; S.c = bx;
        pg8::EpiUp E; E.ACT = ACT; E.outK = nullptr; E.outV = nullptr; E.KB = nullptr; E.VT = nullptr;
        pg8::gemm_phase(lds, DM, DM, S, E);
        TAIL_BEGIN(NMT * (2 * DFF / 256))
            for (int it = tw; it < IT_D; it += ntw) { int r = it; cvt_mat<64>(r, in[I_W2D], DFF, DM, W2D, 0, 0, scr, lane); }
        TAIL_END
    }
    SEAM(11);
    if (IN(12)) {
        pg8::SchedN2 S; S.A = (const char*)ACT; S.B = (const char*)W2D; S.nt = DFF / 64; S.ta = (size_t)256 * DFF * 2; S.tb = (size_t)256 * DFF * 2; S.G = G; S.c = bx; S.minis = true;
        pg8::EpiF32 E; E.F = F; E.SLAB = SLAB;
        pg8::gemm_phase(lds, DFF, DFF, S, E);
    }
    SEAM(12);
    if (IN(13)) { rowop_sample<2>(bx, G, wave, lane, lds, SLAB, DFF / 256, nullptr, H, in[I_G2POST], nullptr, nullptr, out + O_Y);
        rowop<2>(gw, ngw, lane, F, SLAB, DFF / 256, nullptr, nullptr, H, in[I_G2POST], nullptr, nullptr, out + O_Y); }
#undef IN
#undef SEAM
#undef GRID_BAR
#undef TAIL_BEGIN
#undef TAIL_END
}

extern "C" void kernel_launch(void* const* d_in, const int* in_sizes, int n_in, void* d_out, int out_size, void* d_ws, size_t ws_size, hipStream_t stream) {
    static int grid = 0;
    if (grid == 0) {
        if (n_in != N_IN || ws_size < WS_END) { fprintf(stderr, "kernel_launch: expected %d inputs and >= %zu bytes of workspace; got %d, %zu\n", (int)N_IN, (size_t)WS_END, n_in, ws_size); grid = -1; return; }
        int dev = 0, cus = 0, per_cu = 0;
        (void)hipGetDevice(&dev);
        (void)hipDeviceGetAttribute(&cus, hipDeviceAttributeMultiprocessorCount, dev);
        if (hipFuncSetAttribute((const void*)mk_fwd, hipFuncAttributeMaxDynamicSharedMemorySize, LDS_BYTES) != hipSuccess) { fprintf(stderr, "kernel_launch: hipFuncSetAttribute failed\n"); grid = -1; return; }
        if (hipOccupancyMaxActiveBlocksPerMultiprocessor(&per_cu, (const void*)mk_fwd, NTHREADS, LDS_BYTES) != hipSuccess || per_cu < 1) { fprintf(stderr, "kernel_launch: occupancy query says %d\n", per_cu); per_cu = 1; }
        (void)hipGetLastError();
        grid = cus;
        if (grid > cus * per_cu) grid = cus * per_cu;
    }
    if (grid < 0) return;
    Args a{};
    for (int i = 0; i < N_IN; ++i) a.in[i] = (const float*)d_in[i];
    a.out = (float*)d_out; a.ws = (unsigned char*)d_ws;
#if MK_SINGLE
    a.ph_lo = 0; a.ph_hi = NPHASE;
    if (hipMemsetAsync(d_ws, 0, CTL_ZERO_BYTES, stream) != hipSuccess) { fprintf(stderr, "kernel_launch: hipMemsetAsync failed\n"); return; }
    hipLaunchKernelGGL(mk_fwd, dim3(grid), dim3(NTHREADS), LDS_BYTES, stream, a);
#else
    for (int p = 0; p < NPHASE; ++p) {
        a.ph_lo = p; a.ph_hi = p + 1;
        hipLaunchKernelGGL(mk_fwd, dim3(grid), dim3(NTHREADS), LDS_BYTES, stream, a);
    }
#endif
}
```
